# Optimizing an MI355X kernel written in HIP

```python
import math
import jax, jax.numpy as jnp
from jax import lax
import numpy as np

D_MODEL = 1024
BATCH = 8
SEQ = 4096
DEPTH = 2

N_A = DEPTH // 2
N_B = DEPTH - N_A
PLE_DIM = 256
SSM_WIDTH = D_MODEL
SSM_GROUP = 16
SSM_GROUPS = SSM_WIDTH // SSM_GROUP
SSM_STATE = 64
SSM_CHUNK = 128
DT_MIN = 0.001
DT_MAX = 0.1
HEAD_DIM = 64
V_DIM = 2 * HEAD_DIM
N_HEADS = D_MODEL // V_DIM
ATTN_WIDTH = N_HEADS * V_DIM
Q_BLOCK = 128
REL_BUCKETS = 32
REL_MAX_EXACT = REL_BUCKETS // 2
REL_MAX_DIST = 128
EPS = 1e-6
NEG_INF = -1e30

kernel_name = "yoco_s5_diffattn_hybrid"


def rmsnorm(x, g=None):
    xf = x.astype(jnp.float32)
    y = xf * lax.rsqrt(jnp.mean(xf * xf, axis=-1, keepdims=True) + EPS)
    if g is not None:
        y = y * g.astype(jnp.float32)
    return y.astype(x.dtype)


def cmul(ar, ai, br, bi):
    return ar * br - ai * bi, ar * bi + ai * br


def s5_scan(u, lam_re, lam_im, log_dt, b_re, b_im, c_re, c_im, d):
    f32 = jnp.float32
    bsz, seq, _ = u.shape
    uf = u.astype(f32).reshape(bsz, seq, SSM_GROUPS, SSM_GROUP)
    dt = jnp.exp(log_dt.astype(f32))[:, None]
    lr, li = lam_re.astype(f32), lam_im.astype(f32)
    mag = jnp.exp(lr * dt)
    ab_re, ab_im = mag * jnp.cos(li * dt), mag * jnp.sin(li * dt)
    den = lr * lr + li * li
    nr, ni = ab_re - 1.0, ab_im
    f_re = (nr * lr + ni * li) / den
    f_im = (ni * lr - nr * li) / den
    bb_re, bb_im = cmul(f_re[..., None], f_im[..., None], b_re.astype(f32), b_im.astype(f32))
    cr, ci = c_re.astype(f32), c_im.astype(f32)
    n_chunks = seq // SSM_CHUNK
    u_chunks = uf.reshape(bsz, n_chunks, SSM_CHUNK, SSM_GROUPS, SSM_GROUP).transpose(1, 0, 2, 3, 4)
    a_shape = (bsz, SSM_CHUNK, SSM_GROUPS, SSM_STATE)
    a_re = jnp.broadcast_to(ab_re, a_shape)
    a_im = jnp.broadcast_to(ab_im, a_shape)

    def combine(e1, e2):
        a1r, a1i, b1r, b1i = e1
        a2r, a2i, b2r, b2i = e2
        ar, ai = cmul(a2r, a2i, a1r, a1i)
        br, bi = cmul(a2r, a2i, b1r, b1i)
        return ar, ai, br + b2r, bi + b2i

    def chunk_step(carry, uc):
        h_re, h_im = carry
        bu_re = jnp.einsum('btgc,gpc->btgp', uc, bb_re)
        bu_im = jnp.einsum('btgc,gpc->btgp', uc, bb_im)
        pr, pi, sr, si = lax.associative_scan(combine, (a_re, a_im, bu_re, bu_im), axis=1)
        hr, hi = cmul(pr, pi, h_re[:, None], h_im[:, None])
        sr, si = sr + hr, si + hi
        y = jnp.einsum('btgp,gcp->btgc', sr, cr) - jnp.einsum('btgp,gcp->btgc', si, ci)
        return (sr[:, -1], si[:, -1]), y

    init = (jnp.zeros((bsz, SSM_GROUPS, SSM_STATE), f32), jnp.zeros((bsz, SSM_GROUPS, SSM_STATE), f32))
    _, ys = lax.scan(chunk_step, init, u_chunks)
    y = ys.transpose(1, 0, 2, 3, 4).reshape(bsz, seq, SSM_WIDTH)
    y = y + d.astype(f32) * uf.reshape(bsz, seq, SSM_WIDTH)
    return y.astype(u.dtype)


def ssm_layer(x, norm_g, w_in, lam_re, lam_im, log_dt, b_re, b_im, c_re, c_im, d, w_glu, w_out):
    h = rmsnorm(x, norm_g)
    u, z = jnp.split(h @ w_in, 2, axis=-1)
    y = jax.nn.gelu(s5_scan(u, lam_re, lam_im, log_dt, b_re, b_im, c_re, c_im, d))
    ga, gb = jnp.split(y @ w_glu, 2, axis=-1)
    y = ga * jax.nn.sigmoid(gb)
    return (y * jax.nn.silu(z)) @ w_out


def shared_kv(x, kv_norm_g, w_k, w_v, k_norm_g):
    bsz, seq, _ = x.shape
    h = rmsnorm(x, kv_norm_g)
    k = rmsnorm((h @ w_k).reshape(bsz, seq, N_HEADS, 2, HEAD_DIM), k_norm_g)
    v = (h @ w_v).reshape(bsz, seq, N_HEADS, V_DIM)
    return k, v


def rel_bucket(rel):
    n = jnp.maximum(rel, 0)
    nf = jnp.maximum(n, 1).astype(jnp.float32)
    large = REL_MAX_EXACT + (jnp.log(nf / REL_MAX_EXACT) / math.log(REL_MAX_DIST / REL_MAX_EXACT)
                             * (REL_BUCKETS - REL_MAX_EXACT)).astype(jnp.int32)
    large = jnp.minimum(large, REL_BUCKETS - 1)
    return jnp.where(n < REL_MAX_EXACT, n, large)


def diff_attn_layer(x, k, v, rel_bias, layer_idx, norm_g, w_in, q_norm_g,
                    lam_q1, lam_k1, lam_q2, lam_k2, subln_g, w_out):
    f32 = jnp.float32
    bsz, seq, _ = x.shape
    h = rmsnorm(x, norm_g)
    q, z = jnp.split(h @ w_in, 2, axis=-1)
    q = rmsnorm(q.reshape(bsz, seq, N_HEADS, 2, HEAD_DIM), q_norm_g)
    lam_init = 0.8 - 0.6 * math.exp(-0.3 * layer_idx)
    lam = (jnp.exp(jnp.sum(lam_q1.astype(f32) * lam_k1.astype(f32)))
           - jnp.exp(jnp.sum(lam_q2.astype(f32) * lam_k2.astype(f32))) + lam_init)
    n_blocks = seq // Q_BLOCK
    qb = q.reshape(bsz, n_blocks, Q_BLOCK, N_HEADS, 2, HEAD_DIM).transpose(1, 0, 2, 3, 4, 5)
    k_pos = jnp.arange(seq, dtype=jnp.int32)
    scale = HEAD_DIM ** -0.5
    table = rel_bias.astype(f32)

    def block(args):
        q_blk, blk = args
        q_pos = blk * Q_BLOCK + jnp.arange(Q_BLOCK, dtype=jnp.int32)
        rel = q_pos[:, None] - k_pos[None, :]
        bias = table[rel_bucket(rel)].transpose(2, 0, 1)
        s = jnp.einsum('bqhcd,bkhcd->bchqk', q_blk, k, preferred_element_type=f32) * scale + bias
        s = jnp.where(rel >= 0, s, NEG_INF)
        pm = jax.nn.softmax(s, axis=-1)
        attn = pm[:, 0] - lam * pm[:, 1]
        return jnp.einsum('bhqk,bkhe->bqhe', attn.astype(v.dtype), v)

    o = lax.map(block, (qb, jnp.arange(n_blocks, dtype=jnp.int32)))
    o = o.transpose(1, 0, 2, 3, 4).reshape(bsz, seq, N_HEADS, V_DIM)
    o = (rmsnorm(o, subln_g) * (1.0 - lam_init)).reshape(bsz, seq, ATTN_WIDTH)
    return (o * jax.nn.silu(z)) @ w_out


def per_layer_embed(x, p_i, w_proj, w_gate):
    return x + jax.nn.sigmoid(rmsnorm(x) @ w_gate) * (p_i @ w_proj)


def setup_inputs(seed: int = 0) -> dict:
    key = jax.random.key(seed)
    ks = iter(jax.random.split(key, 40))

    def nrm(shape, std):
        return jax.random.normal(next(ks), shape, jnp.float32) * std

    def gain(shape):
        return 1.0 + nrm(shape, 0.02)

    E, G, P, C = SSM_WIDTH, SSM_GROUPS, SSM_STATE, SSM_GROUP
    inp = {}
    inp['x'] = nrm((BATCH, SEQ, D_MODEL), 1.0)
    inp['p'] = nrm((DEPTH, BATCH, SEQ, PLE_DIM), 1.0)
    inp['a_norm_g'] = gain((N_A, D_MODEL))
    inp['a_w_in'] = nrm((N_A, D_MODEL, 2 * E), D_MODEL ** -0.5)
    inp['a_lam_re'] = -0.5 + nrm((N_A, G, P), 0.01)
    inp['a_lam_im'] = jnp.float32(math.pi) * jnp.arange(P, dtype=jnp.float32) + nrm((N_A, G, P), 0.01)
    inp['a_log_dt'] = jax.random.uniform(next(ks), (N_A, G), jnp.float32, math.log(DT_MIN), math.log(DT_MAX))
    inp['a_b_re'] = nrm((N_A, G, P, C), (2 * C) ** -0.5)
    inp['a_b_im'] = nrm((N_A, G, P, C), (2 * C) ** -0.5)
    inp['a_c_re'] = nrm((N_A, G, C, P), 0.5)
    inp['a_c_im'] = nrm((N_A, G, C, P), 0.5)
    inp['a_d'] = nrm((N_A, E), 1.0)
    inp['a_w_glu'] = nrm((N_A, E, 2 * E), E ** -0.5)
    inp['a_w_out'] = nrm((N_A, E, D_MODEL), E ** -0.5)
    inp['kv_norm_g'] = gain((D_MODEL,))
    inp['w_k'] = nrm((D_MODEL, N_HEADS * 2 * HEAD_DIM), D_MODEL ** -0.5)
    inp['w_v'] = nrm((D_MODEL, N_HEADS * V_DIM), D_MODEL ** -0.5)
    inp['k_norm_g'] = gain((HEAD_DIM,))
    inp['b_norm_g'] = gain((N_B, D_MODEL))
    inp['b_w_in'] = nrm((N_B, D_MODEL, N_HEADS * 2 * HEAD_DIM + ATTN_WIDTH), D_MODEL ** -0.5)
    inp['b_q_norm_g'] = gain((N_B, HEAD_DIM))
    inp['b_lam_q1'] = nrm((N_B, HEAD_DIM), 0.1)
    inp['b_lam_k1'] = nrm((N_B, HEAD_DIM), 0.1)
    inp['b_lam_q2'] = nrm((N_B, HEAD_DIM), 0.1)
    inp['b_lam_k2'] = nrm((N_B, HEAD_DIM), 0.1)
    inp['b_subln_g'] = gain((N_B, V_DIM))
    inp['b_w_out'] = nrm((N_B, ATTN_WIDTH, D_MODEL), ATTN_WIDTH ** -0.5)
    inp['rel_bias'] = nrm((REL_BUCKETS, N_HEADS), 0.5)
    inp['ple_w_proj'] = nrm((DEPTH, PLE_DIM, D_MODEL), 0.5 * PLE_DIM ** -0.5)
    inp['ple_w_gate'] = nrm((DEPTH, D_MODEL, D_MODEL), D_MODEL ** -0.5)
    return inp


def reference(x, p, a_norm_g, a_w_in, a_lam_re, a_lam_im, a_log_dt, a_b_re, a_b_im,
              a_c_re, a_c_im, a_d, a_w_glu, a_w_out, kv_norm_g, w_k, w_v, k_norm_g,
              b_norm_g, b_w_in, b_q_norm_g, b_lam_q1, b_lam_k1, b_lam_q2, b_lam_k2,
              b_subln_g, b_w_out, rel_bias, ple_w_proj, ple_w_gate):
    k = v = None
    for i in range(DEPTH):
        if i < N_A:
            j = i
            x = x + ssm_layer(x, a_norm_g[j], a_w_in[j], a_lam_re[j], a_lam_im[j], a_log_dt[j],
                              a_b_re[j], a_b_im[j], a_c_re[j], a_c_im[j], a_d[j], a_w_glu[j], a_w_out[j])
        else:
            if i == N_A:
                k, v = shared_kv(x, kv_norm_g, w_k, w_v, k_norm_g)
            j = i - N_A
            x = x + diff_attn_layer(x, k, v, rel_bias, i, b_norm_g[j], b_w_in[j], b_q_norm_g[j],
                                    b_lam_q1[j], b_lam_k1[j], b_lam_q2[j], b_lam_k2[j],
                                    b_subln_g[j], b_w_out[j])
        x = per_layer_embed(x, p[i], ple_w_proj[i], ple_w_gate[i])
    return x
```

```cpp
#include <hip/hip_runtime.h>
#include <hip/hip_cooperative_groups.h>
#include <cstdio>
#include <cstdint>
#include <cmath>
namespace cg = cooperative_groups;

#ifndef MK_N_LAUNCHES
#define MK_N_LAUNCHES 1
#endif

#ifndef PROBE_MASK
#define PROBE_MASK 0
#endif

#define LAS __attribute__((address_space(3)))
typedef unsigned short bf16_t;
typedef short bf16x8 __attribute__((ext_vector_type(8)));
typedef short s16x4 __attribute__((ext_vector_type(4)));
typedef float f32x2 __attribute__((ext_vector_type(2)));
typedef float f32x4 __attribute__((ext_vector_type(4)));
typedef float f32x16 __attribute__((ext_vector_type(16)));
typedef unsigned u32x2 __attribute__((ext_vector_type(2)));
typedef unsigned u32x4 __attribute__((ext_vector_type(4)));
typedef __bf16 bf16x2_t __attribute__((ext_vector_type(2)));

constexpr int BATCH = 8, SEQ = 4096, DM = 1024, M = BATCH * SEQ, PLE = 256;
constexpr int NG = 64, GC = 16, NP = 64, TC = 16, NCK = SEQ / TC, NCHUNK = BATCH * NCK;
constexpr int KX = 128 + TC * GC;
constexpr int NH = 8;
constexpr float EPS = 1e-6f;
constexpr float LOG2E = 1.4426950408889634f;
constexpr float LAM_INIT = 0.35550906759096926f;

constexpr size_t MiB = 1u << 20;
constexpr size_t WS_SS0 = 1 * MiB, WS_SSP1 = 2 * MiB, WS_SSP2 = 4 * MiB, WS_SSP3 = 6 * MiB, WS_AT = 8 * MiB;
constexpr size_t WS_W_IN0 = 9 * MiB, WS_W_GLU = 13 * MiB, WS_W_OUT0 = 17 * MiB, WS_W_GATE0 = 19 * MiB, WS_W_QKV = 21 * MiB, WS_W_OUT1 = 29 * MiB, WS_W_GATE1 = 31 * MiB,
                 WS_W_PROJ0 = 33 * MiB, WS_W_PROJ1 = 33 * MiB + 512 * 1024;
constexpr size_t WS_R1 = 34 * MiB, WS_R2 = 98 * MiB, WS_R3 = 162 * MiB, WS_R4 = 226 * MiB, WS_R5 = 290 * MiB, WS_R6 = 370 * MiB, WS_R7 = 402 * MiB, WS_R8 = 466 * MiB, WS_END = 498 * MiB;
constexpr size_t WS_PP1 = WS_R1, WS_PP0 = WS_R2, WS_K = WS_R2, WS_XB = WS_R1, WS_YB = WS_R3, WS_X1B = WS_R3, WS_Q = WS_R3, WS_OG = WS_R3, WS_X3B = WS_R5,
                 WS_SZ0 = WS_R4, WS_X2B = WS_R4, WS_AEXT = WS_R5, WS_GB = WS_R5, WS_V = WS_R5, WS_PB = WS_R8, WS_S = WS_R2,
                 WS_W1S = WS_R7, WS_BTS = WS_R7 + 8 * MiB, WS_SZ1 = WS_R7;

__device__ __forceinline__ float sum_fq(float s) {
    auto a = __builtin_amdgcn_permlane32_swap(__builtin_bit_cast(unsigned, s), __builtin_bit_cast(unsigned, s), false, false);
    s = __builtin_bit_cast(float, (unsigned)a[0]) + __builtin_bit_cast(float, (unsigned)a[1]);
    auto b = __builtin_amdgcn_permlane16_swap(__builtin_bit_cast(unsigned, s), __builtin_bit_cast(unsigned, s), false, false);
    return __builtin_bit_cast(float, (unsigned)b[0]) + __builtin_bit_cast(float, (unsigned)b[1]);
}
__device__ __forceinline__ size_t ln_off(int row, int col) {
    const int tile = (row >> 8) * 4 + (col >> 8), rl = row & 255, cl = col & 255;
    const int wid = ((rl >> 6) & 1) * 4 + ((cl >> 5) & 3), piece = (rl >> 7) * 8 + ((rl >> 4) & 3) * 2 + (cl >> 7), ln = ((cl >> 3) & 3) * 16 + (rl & 15);
    return (((size_t)tile * 8 + wid) * 16 + piece) * 512 + (size_t)ln * 8 + (cl & 7);
}
__device__ __forceinline__ unsigned cvtpk(float lo, float hi) { f32x2 v = {lo, hi}; bf16x2_t b = __builtin_convertvector(v, bf16x2_t); return __builtin_bit_cast(unsigned, b); }
__device__ __forceinline__ bf16_t f2bf(float f) { unsigned u = __builtin_bit_cast(unsigned, f); return (bf16_t)((u + 0x7fffu + ((u >> 16) & 1u)) >> 16); }
__device__ __forceinline__ float bf2f(unsigned short b) { return __builtin_bit_cast(float, (unsigned)b << 16); }
__device__ __forceinline__ float bflo(unsigned w) { return __builtin_bit_cast(float, w << 16); }
__device__ __forceinline__ float bfhi(unsigned w) { return __builtin_bit_cast(float, w & 0xffff0000u); }
__device__ __forceinline__ u32x4 pack8(f32x4 a, f32x4 b) { u32x4 w; w.x = cvtpk(a[0], a[1]); w.y = cvtpk(a[2], a[3]); w.z = cvtpk(b[0], b[1]); w.w = cvtpk(b[2], b[3]); return w; }
__device__ __forceinline__ void unpack8(u32x4 w, f32x4& a, f32x4& b) { a = (f32x4){bflo(w.x), bfhi(w.x), bflo(w.y), bfhi(w.y)}; b = (f32x4){bflo(w.z), bfhi(w.z), bflo(w.w), bfhi(w.w)}; }
__device__ __forceinline__ float sigmoidf_(float x) { return __builtin_amdgcn_rcpf(1.0f + __builtin_amdgcn_exp2f(-LOG2E * x)); }
__device__ __forceinline__ float siluf_(float x) { return x * sigmoidf_(x); }
__device__ __forceinline__ float gelu_tanh(float x) { const float t = x + 0.044715f * x * x * x; return x * __builtin_amdgcn_rcpf(1.0f + __builtin_amdgcn_exp2f(-2.302208198f * t)); }
__device__ __forceinline__ f32x4 sig4(f32x4 v) { return (f32x4){sigmoidf_(v[0]), sigmoidf_(v[1]), sigmoidf_(v[2]), sigmoidf_(v[3])}; }
__device__ __forceinline__ f32x4 silu4(f32x4 v) { return (f32x4){siluf_(v[0]), siluf_(v[1]), siluf_(v[2]), siluf_(v[3])}; }
__device__ __forceinline__ f32x4 gelu4(f32x4 v) { return (f32x4){gelu_tanh(v[0]), gelu_tanh(v[1]), gelu_tanh(v[2]), gelu_tanh(v[3])}; }
__device__ __forceinline__ float sumsq4(f32x4 v) { return (v[0] * v[0] + v[1] * v[1]) + (v[2] * v[2] + v[3] * v[3]); }
__device__ __forceinline__ float wave_sum(float v) {
    v += __builtin_bit_cast(float, __builtin_amdgcn_update_dpp(0, __builtin_bit_cast(int, v), 0xB1, 0xF, 0xF, true));
    v += __builtin_bit_cast(float, __builtin_amdgcn_update_dpp(0, __builtin_bit_cast(int, v), 0x4E, 0xF, 0xF, true));
    v += __builtin_bit_cast(float, __builtin_amdgcn_update_dpp(0, __builtin_bit_cast(int, v), 0x141, 0xF, 0xF, true));
    v += __builtin_bit_cast(float, __builtin_amdgcn_update_dpp(0, __builtin_bit_cast(int, v), 0x140, 0xF, 0xF, true));
    return sum_fq(v);
}

namespace pg8 {
constexpr int BM = 256, BK = 64, HALF = 128, HTB = HALF * BK * 2, STAGE_BYTES = 8 * HTB, NXCD = 8, WGM = 8;
__host__ __device__ __forceinline__ int lds_byte(int r, int c) { const int st = (r >> 4) * 2 + (c >> 5), rr = r & 15, cc = c & 31, ob = rr * 64 + cc * 2; return st * 1024 + (ob ^ (((ob >> 9) & 1) << 5)); }
__host__ __device__ __forceinline__ void stage_rc(int b, int& R, int& C) { const int st = b / 1024, sb = b % 1024, swz = sb ^ (((sb >> 9) & 1) << 5); R = (st >> 1) * 16 + swz / 64; C = (st & 1) * 32 + (swz % 64) / 2; }
__host__ __device__ __forceinline__ int perm32(int rho) { const int n = rho >> 4, i = rho & 15; return 8 * (i >> 2) + 4 * n + (i & 3); }

struct Unit { int pm, pn, nt; };
struct Gemm { const bf16_t* A; const bf16_t* Bt; int lda, ldb; };

struct StaticOrder {
    int nM, nN, nwg, G, c, nt;
    __device__ void init(int M_, int N_, int K_, int G_, int c_) { nM = M_ / BM; nN = N_ / BM; nwg = nM * nN; G = G_; c = c_; nt = K_ / BK; }
    __device__ bool next(int i, Unit& u) const {
        const long L = (long)i * G + c; if (L >= nwg) return false;
        int wgid = (int)L; { const int q = nwg / NXCD, r = nwg % NXCD, xcd = wgid % NXCD, off = wgid / NXCD; wgid = (xcd < r ? xcd * (q + 1) : r * (q + 1) + (xcd - r) * q) + off; }
        const int nig = WGM * nN, gid = wgid / nig, fm = gid * WGM, gsz = (nM - fm) < WGM ? (nM - fm) : WGM;
        u.pm = fm + ((wgid % nig) % gsz); u.pn = (wgid % nig) / gsz; u.nt = nt; return true;
    }
};
struct DualOrder {
    StaticOrder so; bool xl; int X, k, nrounds;
    __device__ void init(int M_, int N_, int K_, int G_, int c_, bool xl_, int X_, int k_) { so.init(M_, N_, K_, G_, c_); xl = xl_; X = X_; k = k_; nrounds = N_ / BM / 2; }
    __device__ bool next(int i, Unit& u) const {
        if (!xl) return so.next(i, u);
        if (i >= nrounds) return false;
        u.pm = 16 * X + (k & 7) + 8 * (i & 1); u.pn = (k >> 3) + 4 * (i >> 1); u.nt = so.nt; return true;
    }
};
struct SsmOrder {
    int G, v; bool xl; int XI, KR;
    __device__ bool next(int i, Unit& u) const {
        int g, b;
        if (xl) { if (i >= 2) return false; g = KR * 2 + i; b = XI; }
        else { const int L = i * G + v; if (L >= 512) return false; g = L >> 3; b = L & 7; }
        int nt = KX / BK; asm volatile("" : "+s"(nt));
        u.pm = g * 8 + b; u.pn = g; u.nt = nt; return true;
    }
};

template <class Epi, class Sched, bool ALIGN_EPI, int AMODE = 0>
__device__ __forceinline__ void gemm_phase(LAS unsigned char* lds, const Gemm g, const Sched& S, const Epi& E) {
    int tid = threadIdx.x; asm volatile("" : "+v"(tid));
    const int wid = __builtin_amdgcn_readfirstlane(tid >> 6), lane = tid & 63, wr = wid >> 2, wc = wid & 3, fr = lane & 15, fq = lane >> 4;
    unsigned voffA[2], voffB[2];
#pragma unroll
    for (int i = 0; i < 2; ++i) { int R, C; stage_rc(tid * 16 + i * 8192, R, C); const int Rb = Epi::PERM ? ((R & ~31) + perm32(R & 31)) : R;
        voffA[i] = AMODE == 1 ? (unsigned)(((C >> 4) * g.lda + R) * 16 + (C & 15)) * 2u
                 : (AMODE == 3 ? (unsigned)(((((R >> 6) & 1) * 4 + ((C >> 5) & 1)) * 16 + ((R >> 4) & 3) * 2) * 1024 + (tid & 63) * 16) : (unsigned)(R * g.lda + C) * 2u);
        voffB[i] = (unsigned)(Rb * g.ldb + C) * 2u; }
    const size_t kstep = (size_t)(BK * 2), kstepA = AMODE == 1 ? (size_t)(BK / 16) * g.lda * 32 : kstep;
    auto AK = [&](int kt) -> size_t { if constexpr (AMODE == 3) return (size_t)(kt >> 2) * 131072 + (size_t)(kt & 1) * 32768 + (size_t)((kt >> 1) & 1) * 1024; else return (size_t)kt * kstepA; };
    const size_t hstepA = AMODE == 1 ? (size_t)HALF * 32 : (AMODE == 3 ? (size_t)8192 : (size_t)HALF * g.lda * 2), hstepB = (size_t)HALF * g.ldb * 2;
    const size_t tstepA = AMODE == 3 ? (size_t)524288 : 2 * hstepA, tstepB = 2 * hstepB;
    const unsigned ldsw = (unsigned)wid * 1024u;
    const int aoff = AMODE == 3 ? wr * 8192 + lane * 16 : lds_byte(wr * 64 + fr, fq * 8), boff = lds_byte(wc * 32 + fr, fq * 8);
#define PG8_SA(b, h) (((b) * 2 + (h)) * HTB)
#define PG8_SB(b, h) ((4 + (b) * 2 + (h)) * HTB)
#define PG8_STAGE(bufoff, gbase, voff) do { _Pragma("unroll") for (int _i = 0; _i < 2; ++_i) \
        __builtin_amdgcn_global_load_lds((const unsigned*)((const char*)(gbase) + (voff)[_i]), (LAS unsigned*)(lds + (bufoff) + ldsw + _i * 8192), 16, 0, 0); } while (0)
#define PG8_LDA(dst, b, h) do { _Pragma("unroll") for (int m = 0; m < 4; ++m) _Pragma("unroll") for (int k = 0; k < 2; ++k) dst[m][k] = *(const LAS bf16x8*)(lds + PG8_SA(b, h) + aoff + m * 2048 + k * 1024); } while (0)
#define PG8_LDB(dst, b, h) do { _Pragma("unroll") for (int n = 0; n < 2; ++n) _Pragma("unroll") for (int k = 0; k < 2; ++k) dst[n][k] = *(const LAS bf16x8*)(lds + PG8_SB(b, h) + boff + n * 2048 + k * 1024); } while (0)
#define PG8_MMA(ai, bj, At, Bt) do { __builtin_amdgcn_s_setprio(1); _Pragma("unroll") for (int m = 0; m < 4; ++m) _Pragma("unroll") for (int n = 0; n < 2; ++n) _Pragma("unroll") for (int k = 0; k < 2; ++k) \
        acc[ai][bj][m][n] = __builtin_amdgcn_mfma_f32_16x16x32_bf16(Bt[n][k], At[m][k], acc[ai][bj][m][n], 0, 0, 0); __builtin_amdgcn_s_setprio(0); } while (0)
#define PG8_WAIT_V(n) asm volatile("s_waitcnt vmcnt(" #n ")" ::: "memory")
#define PG8_WAIT_L(n) asm volatile("s_waitcnt lgkmcnt(" #n ")" ::: "memory")
#define PG8_BAR __builtin_amdgcn_s_barrier()
#define PG8_SCHED __builtin_amdgcn_sched_barrier(0)
    Unit cur, nxt; int ui = 0;
    if (!S.next(0, cur)) return;
    f32x4 acc[2][2][4][2];
#pragma unroll
    for (int a = 0; a < 2; ++a)
#pragma unroll
        for (int b = 0; b < 2; ++b)
#pragma unroll
            for (int m = 0; m < 4; ++m)
#pragma unroll
                for (int n = 0; n < 2; ++n) acc[a][b][m][n] = (f32x4){0.f, 0.f, 0.f, 0.f};
    bf16x8 At[4][2], B0[2][2], B1[2][2];
    const char* cA = (const char*)g.A + (size_t)cur.pm * tstepA; const char* cB = (const char*)g.Bt + (size_t)cur.pn * tstepB;
    PG8_STAGE(PG8_SB(0, 0), cB, voffB); PG8_STAGE(PG8_SB(0, 1), cB + hstepB, voffB); PG8_STAGE(PG8_SA(0, 0), cA, voffA); PG8_STAGE(PG8_SA(0, 1), cA + hstepA, voffA);
    if (wr == 1) PG8_BAR;
    PG8_WAIT_V(2); PG8_BAR;
    PG8_STAGE(PG8_SB(1, 0), cB + kstep, voffB); PG8_STAGE(PG8_SA(1, 0), cA + AK(1), voffA); PG8_STAGE(PG8_SB(1, 1), cB + hstepB + kstep, voffB);
    PG8_WAIT_V(6); PG8_BAR;
    for (;;) {
        const bool has_next = S.next(ui + 1, nxt);
        const char* nA = has_next ? (const char*)g.A + (size_t)nxt.pm * tstepA : cA; const char* nB = has_next ? (const char*)g.Bt + (size_t)nxt.pn * tstepB : cB;
        const int nt = cur.nt;
        for (int t = 0; t < nt; t += 2) {
            const bool last = (t == nt - 2);
            const char* a1 = cA + AK(t + 1);
            const char* a2 = last ? nA : cA + AK(t + 2); const char* b2 = last ? nB : cB + (size_t)(t + 2) * kstep;
            const char* a3 = last ? nA + AK(1) : cA + AK(t + 3); const char* b3 = b2 + kstep;
            PG8_LDB(B0, 0, 0); PG8_LDB(B1, 0, 1); PG8_SCHED; PG8_LDA(At, 0, 0); PG8_STAGE(PG8_SA(1, 1), a1 + hstepA, voffA);
            PG8_WAIT_V(8); PG8_WAIT_L(0); PG8_BAR; PG8_MMA(0, 0, At, B0); PG8_MMA(0, 1, At, B1); PG8_BAR; PG8_SCHED;
            PG8_LDA(At, 0, 1); PG8_STAGE(PG8_SB(0, 0), b2, voffB); PG8_STAGE(PG8_SB(0, 1), b2 + hstepB, voffB); PG8_STAGE(PG8_SA(0, 0), a2, voffA);
            PG8_WAIT_V(8); PG8_WAIT_L(0); PG8_BAR; PG8_MMA(1, 0, At, B0); PG8_MMA(1, 1, At, B1); PG8_BAR; PG8_SCHED;
            PG8_LDB(B0, 1, 0); PG8_LDB(B1, 1, 1); PG8_SCHED; PG8_LDA(At, 1, 0); PG8_STAGE(PG8_SA(0, 1), a2 + hstepA, voffA);
            PG8_WAIT_V(8); PG8_WAIT_L(0); PG8_BAR; PG8_MMA(0, 0, At, B0); PG8_MMA(0, 1, At, B1); PG8_BAR; PG8_SCHED;
            PG8_LDA(At, 1, 1); PG8_STAGE(PG8_SB(1, 0), b3, voffB); PG8_STAGE(PG8_SB(1, 1), b3 + hstepB, voffB); PG8_STAGE(PG8_SA(1, 0), a3, voffA);
            PG8_WAIT_V(8); PG8_WAIT_L(0); PG8_BAR; PG8_MMA(1, 0, At, B0); PG8_MMA(1, 1, At, B1); PG8_BAR; PG8_SCHED;
        }
        if constexpr (ALIGN_EPI) { if (wr == 0) PG8_BAR; }
        { int pm_ = cur.pm, pn_ = cur.pn; asm volatile("" : "+s"(pm_), "+s"(pn_)); cur.pm = pm_; cur.pn = pn_; }
        E(acc, cur, wr, wc, fr, fq);
        if (!has_next) break;
#pragma unroll
        for (int a = 0; a < 2; ++a)
#pragma unroll
            for (int b = 0; b < 2; ++b)
#pragma unroll
                for (int m = 0; m < 4; ++m)
#pragma unroll
                    for (int n = 0; n < 2; ++n) acc[a][b][m][n] = (f32x4){0.f, 0.f, 0.f, 0.f};
        cur = nxt; cA = nA; cB = nB; ++ui;
        if constexpr (ALIGN_EPI) { if (wr == 1) PG8_BAR; }
    }
    PG8_WAIT_V(0);
    if constexpr (!ALIGN_EPI) { if (wr == 0) PG8_BAR; }
    PG8_BAR;
#undef PG8_SA
#undef PG8_SB
#undef PG8_STAGE
#undef PG8_LDA
#undef PG8_LDB
#undef PG8_MMA
#undef PG8_WAIT_V
#undef PG8_WAIT_L
#undef PG8_BAR
#undef PG8_SCHED
}

#define EPI_ROW(u, ai, m) ((u).pm * BM + (ai) * HALF + wr * 64 + (m) * 16 + fr)
typedef const f32x4 (&AccRef)[2][2][4][2];
#define LN_OFF(tile, ai, m, bj) ((((size_t)(tile) * 8 + (wr * 4 + wc)) * 2 + (ai)) * 4096 + (size_t)(fq * 16 + fr) * 8 + 2048 + (((m) * 2 + (bj)) * 512 - 2048))

__device__ __forceinline__ void row_scales(const float* ssp, const Unit& u, int wr, int fr, int fq, float (&r)[2][4]) {
    f32x4 p[2][4];
#pragma unroll
    for (int ai = 0; ai < 2; ++ai)
#pragma unroll
        for (int m = 0; m < 4; ++m) p[ai][m] = *(const f32x4*)(ssp + (size_t)EPI_ROW(u, ai, m) * 16 + 4 * fq);
#pragma unroll
    for (int ai = 0; ai < 2; ++ai)
#pragma unroll
        for (int m = 0; m < 4; ++m) { float s = (p[ai][m][0] + p[ai][m][1]) + (p[ai][m][2] + p[ai][m][3]); s += __shfl_xor(s, 16); s += __shfl_xor(s, 32); r[ai][m] = rsqrtf(s * (1.0f / DM) + EPS); }
}
constexpr int LDS_RS_OFF = 131072;
__device__ __forceinline__ void row_scales_to_lds(const float* ssp, int pm0, LAS float* rlds) {
    const int tid = threadIdx.x, slot = tid >> 8, rowl = tid & 255;
    const f32x4* sp = (const f32x4*)(ssp + ((size_t)(pm0 + 8 * slot) * BM + rowl) * 16);
    const f32x4 s4 = (sp[0] + sp[1]) + (sp[2] + sp[3]);
    rlds[tid] = rsqrtf(((s4[0] + s4[1]) + (s4[2] + s4[3])) * (1.0f / DM) + EPS);
    __syncthreads();
}
__device__ __forceinline__ void row_scales1_to_lds(const float* ss, int pm0, LAS float* rlds) {
    const int tid = threadIdx.x, slot = tid >> 8, rowl = tid & 255;
    rlds[tid] = rsqrtf(ss[(size_t)(pm0 + 8 * slot) * BM + rowl] * (1.0f / DM) + EPS);
    __syncthreads();
}
__device__ __forceinline__ void row_scales_from_lds(const LAS float* rlds, const Unit& u, int wr, int fr, float (&r)[2][4]) {
    const LAS float* p = rlds + ((u.pm >> 3) & 1) * 256 + wr * 64 + fr;
#pragma unroll
    for (int ai = 0; ai < 2; ++ai)
#pragma unroll
        for (int m = 0; m < 4; ++m) r[ai][m] = p[ai * HALF + m * 16];
}
struct EpiInProj {
    static constexpr bool PERM = true;
    const float* ss0; bf16_t* aext; bf16_t* sz; const LAS float* rlds;
    __device__ __forceinline__ void operator()(AccRef acc, const Unit& u, int wr, int wc, int fr, int fq) const {
        float sr[2][4];
        if (rlds) row_scales_from_lds(rlds, u, wr, fr, sr);
        else {
#pragma unroll
            for (int ai = 0; ai < 2; ++ai)
#pragma unroll
                for (int m = 0; m < 4; ++m) sr[ai][m] = ss0[EPI_ROW(u, ai, m)];
#pragma unroll
            for (int ai = 0; ai < 2; ++ai)
#pragma unroll
                for (int m = 0; m < 4; ++m) sr[ai][m] = rsqrtf(sr[ai][m] * (1.0f / DM) + EPS);
        }
#pragma unroll
        for (int ai = 0; ai < 2; ++ai)
#pragma unroll
            for (int m = 0; m < 4; ++m) {
                const int row = EPI_ROW(u, ai, m); const float r = sr[ai][m];
#pragma unroll
                for (int bj = 0; bj < 2; ++bj) {
                    const int col8 = u.pn * BM + bj * HALF + wc * 32 + 8 * fq;
                    f32x4 v0 = acc[ai][bj][m][0] * r, v1 = acc[ai][bj][m][1] * r;
                    if (u.pn < 4) { const int g = col8 >> 4, cc = col8 & 15, chunk = row / TC, s = row % TC;
                        *(u32x4*)(aext + ((size_t)(g * NCHUNK + chunk) * KX + 128 + s * 16 + cc)) = pack8(v0, v1); }
                    else *(u32x4*)(sz + LN_OFF(u.pm * 4 + (u.pn - 4), ai, m, bj)) = pack8(silu4(v0), silu4(v1));
                }
            }
    }
};
struct EpiStore {
    static constexpr bool PERM = true;
    bf16_t* o;
    __device__ __forceinline__ void operator()(AccRef acc, const Unit& u, int wr, int wc, int fr, int fq) const {
#pragma unroll
        for (int ai = 0; ai < 2; ++ai)
#pragma unroll
            for (int m = 0; m < 4; ++m) {
#pragma unroll
                for (int bj = 0; bj < 2; ++bj) *(u32x4*)(o + LN_OFF(u.pm * 4 + u.pn, ai, m, bj)) = pack8(acc[ai][bj][m][0], acc[ai][bj][m][1]); }
    }
};
struct EpiY {
    static constexpr bool PERM = true;
    bf16_t* yb;
    __device__ __forceinline__ void operator()(AccRef acc, const Unit& u, int wr, int wc, int fr, int fq) const {
        const int g = u.pm >> 3, ir = u.pm & 7;
#pragma unroll
        for (int ai = 0; ai < 2; ++ai)
#pragma unroll
            for (int m = 0; m < 4; ++m) { const int chunk = ir * 256 + ai * HALF + wr * 64 + m * 16 + fr;
#pragma unroll
                for (int bj = 0; bj < 2; ++bj) { const int idx = bj * HALF + wc * 32 + 8 * fq, t = idx >> 4, c = idx & 15;
                    *(u32x4*)(yb + ((size_t)g * M + chunk * TC + t) * GC + c) = pack8(gelu4(acc[ai][bj][m][0]), gelu4(acc[ai][bj][m][1])); } }
    }
};
struct EpiGlu {
    static constexpr bool PERM = true;
    const bf16_t* sz; bf16_t* gb;
    __device__ __forceinline__ void operator()(AccRef acc, const Unit& u, int wr, int wc, int fr, int fq) const {
        u32x4 zq[2][4];
#pragma unroll
        for (int ai = 0; ai < 2; ++ai)
#pragma unroll
            for (int m = 0; m < 4; ++m) zq[ai][m] = __builtin_nontemporal_load((const u32x4*)(sz + LN_OFF(u.pm * 4 + (u.pn >> 1), ai, m, u.pn & 1)));
#pragma unroll
        for (int ai = 0; ai < 2; ++ai)
#pragma unroll
            for (int m = 0; m < 4; ++m) { const size_t off = LN_OFF(u.pm * 4 + (u.pn >> 1), ai, m, u.pn & 1);
                f32x4 z0, z1; unpack8(zq[ai][m], z0, z1);
                const f32x4 o0 = acc[ai][0][m][0] * sig4(acc[ai][1][m][0]) * z0, o1 = acc[ai][0][m][1] * sig4(acc[ai][1][m][1]) * z1;
                *(u32x4*)(gb + off) = pack8(o0, o1); }
    }
};
template <bool BASE_BF16, bool BASE_LN = true> struct EpiOutRes {
    static constexpr bool PERM = true;
    static constexpr int NG = BASE_BF16 ? 8 : 4;
    const float* basef; const bf16_t* baseb; bf16_t* xb; float* ssp;
    __device__ __forceinline__ void operator()(AccRef acc, const Unit& u, int wr, int wc, int fr, int fq) const {
#pragma unroll
        for (int g0 = 0; g0 < 8; g0 += NG) {
            f32x4 bf_[BASE_BF16 ? 1 : NG][2][2]; u32x4 bb_[BASE_BF16 ? NG : 1][2];
#pragma unroll
            for (int gg = 0; gg < NG; ++gg)
#pragma unroll
                for (int bj = 0; bj < 2; ++bj) { const int ai = (g0 + gg) >> 2, m = (g0 + gg) & 3; const size_t off = BASE_LN ? LN_OFF(u.pm * 4 + u.pn, ai, m, bj) : (size_t)EPI_ROW(u, ai, m) * DM + u.pn * BM + bj * HALF + wc * 32 + 8 * fq;
                    if constexpr (BASE_BF16) bb_[gg][bj] = __builtin_nontemporal_load((const u32x4*)(baseb + off)); else { bf_[gg][bj][0] = *(const f32x4*)(basef + off); bf_[gg][bj][1] = *(const f32x4*)(basef + off + 4); } }
#pragma unroll
            for (int gg = 0; gg < NG; ++gg) { const int ai = (g0 + gg) >> 2, m = (g0 + gg) & 3; const int row = EPI_ROW(u, ai, m); float q = 0.f;
#pragma unroll
                for (int bj = 0; bj < 2; ++bj) { const size_t off = LN_OFF(u.pm * 4 + u.pn, ai, m, bj);
                    f32x4 b0, b1;
                    if constexpr (BASE_BF16) unpack8(bb_[gg][bj], b0, b1); else { b0 = bf_[gg][bj][0]; b1 = bf_[gg][bj][1]; }
                    const f32x4 v0 = acc[ai][bj][m][0] + b0, v1 = acc[ai][bj][m][1] + b1;
                    *(u32x4*)(xb + off) = pack8(v0, v1); q += sumsq4(v0) + sumsq4(v1); }
                q = sum_fq(q);
                if (fq == 0) ssp[(size_t)row * 16 + u.pn * 4 + wc] = q; }
        }
    }
};
template <bool FINAL> struct EpiGate {
    static constexpr bool PERM = true;
    static constexpr int NB = 2;
    const bf16_t* xin; const bf16_t* pp; const float* ssp_in; bf16_t* xb; float* ssp_out; float* outf; const LAS float* rlds;
    __device__ __forceinline__ void operator()(AccRef acc, const Unit& u, int wr, int wc, int fr, int fq) const {
        float rs[2][4]; if (rlds) row_scales_from_lds(rlds, u, wr, fr, rs); else row_scales(ssp_in, u, wr, fr, fq, rs);
#pragma unroll
        for (int ai = 0; ai < 2; ++ai)
#pragma unroll
            for (int m0 = 0; m0 < 4; m0 += NB) {
                const bf16_t* ppa = pp + LN_OFF(u.pm * 4 + u.pn, ai, 0, 0) + 2048; asm volatile("" : "+v"(ppa));
                const bf16_t* xa = xin + LN_OFF(u.pm * 4 + u.pn, ai, 0, 0) + 2048; asm volatile("" : "+v"(xa));
                u32x4 pq[NB][2], xq[NB][2];
#pragma unroll
                for (int mm = 0; mm < NB; ++mm)
#pragma unroll
                    for (int bj = 0; bj < 2; ++bj) { pq[mm][bj] = __builtin_nontemporal_load((const u32x4*)(ppa + (((m0 + mm) * 2 + bj) * 512 - 2048))); xq[mm][bj] = *(const u32x4*)(xa + (((m0 + mm) * 2 + bj) * 512 - 2048)); }
#pragma unroll
                for (int mm = 0; mm < NB; ++mm) { const int m = m0 + mm; const int row = EPI_ROW(u, ai, m); const float r = rs[ai][m]; float q = 0.f;
#pragma unroll
                    for (int bj = 0; bj < 2; ++bj) { const size_t off = FINAL ? (size_t)row * DM + u.pn * BM + bj * HALF + wc * 32 + 8 * fq : LN_OFF(u.pm * 4 + u.pn, ai, m, bj);
                        f32x4 p0, p1, x0, x1; unpack8(pq[mm][bj], p0, p1); unpack8(xq[mm][bj], x0, x1);
                        const f32x4 v0 = x0 + sig4(acc[ai][bj][m][0] * r) * p0, v1 = x1 + sig4(acc[ai][bj][m][1] * r) * p1;
                        if (FINAL) { *(f32x4*)(outf + off) = v0; *(f32x4*)(outf + off + 4) = v1; }
                        else { *(u32x4*)(xb + off) = pack8(v0, v1); q += sumsq4(v0) + sumsq4(v1); } }
                    if (!FINAL) { q = sum_fq(q); if (fq == 0) ssp_out[(size_t)row * 16 + u.pn * 4 + wc] = q; } }
            }
    }
};
struct EpiQKV {
    static constexpr bool PERM = true;
    const float* ssp_in; const float* gk; const float* gq; bf16_t* kb; bf16_t* vb; bf16_t* qb; bf16_t* szb; float qscale; const LAS float* rlds;
    __device__ __forceinline__ void operator()(AccRef acc, const Unit& u, int wr, int wc, int fr, int fq) const {
        const int type = u.pn >> 2, colb = 256 * (u.pn & 3) + 64 * wc + 8 * fq;
        bf16_t* const dst = type == 0 ? kb : (type == 1 ? vb : (type == 2 ? qb : szb));
        const float* const gn = type == 0 ? gk : gq;
        f32x4 gv[2][2];
#pragma unroll
        for (int bj = 0; bj < 2; ++bj) { gv[bj][0] = *(const f32x4*)(gn + 32 * bj + 8 * fq); gv[bj][1] = *(const f32x4*)(gn + 32 * bj + 8 * fq + 4); }
        float rs[2][4]; if (rlds) row_scales_from_lds(rlds, u, wr, fr, rs); else row_scales(ssp_in, u, wr, fr, fq, rs);
#pragma unroll
        for (int ai = 0; ai < 2; ++ai)
#pragma unroll
            for (int m = 0; m < 4; ++m) { const int row = EPI_ROW(u, ai, m);
                const float r = rs[ai][m];
                f32x4 t[2][2];
                if (type == 0 || type == 2) {
                    float q = (sumsq4(acc[ai][0][m][0]) + sumsq4(acc[ai][0][m][1])) + (sumsq4(acc[ai][1][m][0]) + sumsq4(acc[ai][1][m][1]));
                    q = sum_fq(q);
                    const float sc = r * rsqrtf(r * r * q * (1.0f / 64.0f) + EPS) * (type == 2 ? qscale : 1.0f);
#pragma unroll
                    for (int bj = 0; bj < 2; ++bj) { t[bj][0] = acc[ai][bj][m][0] * sc * gv[bj][0]; t[bj][1] = acc[ai][bj][m][1] * sc * gv[bj][1]; }
                } else {
#pragma unroll
                    for (int bj = 0; bj < 2; ++bj) { t[bj][0] = acc[ai][bj][m][0] * r; t[bj][1] = acc[ai][bj][m][1] * r; }
                    if (type == 3) {
#pragma unroll
                        for (int bj = 0; bj < 2; ++bj) { t[bj][0] = silu4(t[bj][0]); t[bj][1] = silu4(t[bj][1]); }
                    }
                }
                if (type >= 2) {
#pragma unroll
                    for (int bj = 0; bj < 2; ++bj) *(u32x4*)(dst + (size_t)row * DM + colb + 32 * bj) = pack8(t[bj][0], t[bj][1]);
                } else {
                    const int bb = row >> 12, s = row & (SEQ - 1);
#pragma unroll
                    for (int bj = 0; bj < 2; ++bj) { const int c = colb + 32 * bj, hh = c >> 7, d = c & 127;
                        const size_t tb = ((size_t)((bb * NH + hh) * 64 + (s >> 6))) * 8192;
                        const size_t off = type == 0 ? tb + (d >> 3) * 512 + (s & 63) * 8 : tb + (d >> 5) * 2048 + (s & 63) * 32 + (d & 31);
                        *(u32x4*)(dst + off) = pack8(t[bj][0], t[bj][1]); }
                }
            }
    }
};
}

namespace att {
constexpr int SLOT = 32768, KOFF = 0, VOFF = 16384, NSLOT = 3;
constexpr int LDS_RING = 0, LDS_BT = NSLOT * SLOT, LDS_WSF = LDS_BT + 1024, LDS_MISC = LDS_WSF + 8 * 64 * 4, LDS_TOTAL = LDS_MISC + 64;
constexpr int LDS_EX = 0;
__device__ __forceinline__ int crow(int r, int hi) { return (r & 3) + 8 * (r >> 2) + 4 * hi; }
__device__ __forceinline__ void glds16(const void* gsrc, unsigned lds_dst) { unsigned keep;
    asm volatile("s_mov_b32 %0, m0\n\ts_mov_b32 m0, %2\n\ts_nop 0\n\tglobal_load_lds_dwordx4 %1, off\n\ts_mov_b32 m0, %0" : "=&s"(keep) : "v"(gsrc), "s"(lds_dst) : "memory"); }
__device__ __forceinline__ int t5_bucket(int n) {
    if (n < 16) return n;
    return 16 + (n >= 19) + (n >= 21) + (n >= 24) + (n >= 27) + (n >= 31) + (n >= 35) + (n >= 40) + (n >= 46) + (n >= 52) + (n >= 59) + (n >= 67) + (n >= 77) + (n >= 87) + (n >= 99) + (n >= 113);
}
struct Params { const bf16_t* q; const bf16_t* k; const bf16_t* v; const bf16_t* sz; bf16_t* og; const float* rel_bias; const float* gq; const float* gk;
                const float* lq1; const float* lk1; const float* lq2; const float* lk2; const float* subln; };

__device__ __forceinline__ void attn_unit(const Params& P, int bh, int qb, LAS unsigned char* shm, float lam, float qkmax) {
    const int tid = threadIdx.x, lane = tid & 63, r32 = lane & 31, hi = lane >> 5; const int wid = __builtin_amdgcn_readfirstlane(tid >> 6);
    const int cmap = wid >> 2, wq = wid & 3;
    const int b = bh >> 3, h = bh & 7; const long rowbase = (long)b * SEQ; const int q0 = qb * 128;
    const unsigned lds0 = (unsigned)(uintptr_t)shm;
    LAS float* bt = (LAS float*)(shm + LDS_BT);
    LAS float* wsf = (LAS float*)(shm + LDS_WSF) + wid * 64;
    {
        float bmax = -1e30f;
        for (int i = 0; i < 32; ++i) bmax = fmaxf(bmax, P.rel_bias[i * NH + h]);
        const float Bh = qkmax + bmax;
        if (tid <= 128) { const int n = tid - 1; bt[tid] = (tid == 0) ? -INFINITY : (P.rel_bias[t5_bucket(n) * NH + h] - Bh) * LOG2E; }
    }
    const bf16_t* Kh = P.k + rowbase * DM + h * 128; const bf16_t* Vh = P.v + rowbase * DM + h * 128;
    const bf16_t* ksrc0 = Kh + (long)lane * DM + (2 * wid) * 8; const bf16_t* ksrc1 = ksrc0 + 8;
    const int pc0 = 2 * wid, pc1 = 2 * wid + 1;
    const bf16_t* vsrc0 = Vh + (long)(16 * (pc0 & 3) + (lane >> 2)) * DM + (pc0 >> 2) * 32 + (lane & 3) * 8;
    const bf16_t* vsrc1 = Vh + (long)(16 * (pc1 & 3) + (lane >> 2)) * DM + (pc1 >> 2) * 32 + (lane & 3) * 8;
    const unsigned kdst = lds0 + LDS_RING + KOFF + (2 * wid) * 1024, vdst = lds0 + LDS_RING + VOFF + (2 * wid) * 1024;
#define DMA_TILE(t, slot) do { const long _o = (long)(t) * 64 * DM; const unsigned _s = (unsigned)(slot) * SLOT; \
    glds16(ksrc0 + _o, (unsigned)__builtin_amdgcn_readfirstlane(kdst + _s)); glds16(ksrc1 + _o, (unsigned)__builtin_amdgcn_readfirstlane(kdst + _s + 1024)); \
    glds16(vsrc0 + _o, (unsigned)__builtin_amdgcn_readfirstlane(vdst + _s)); glds16(vsrc1 + _o, (unsigned)__builtin_amdgcn_readfirstlane(vdst + _s + 1024)); } while (0)
    const int NT = 2 * qb + 2;
    DMA_TILE(0, 0); DMA_TILE(1, 1);
    const bf16_t* Qw = P.q + (rowbase + q0 + wq * 32 + r32) * DM + h * 128 + cmap * 64 + hi * 8;
    bf16x8 qr[4];
#pragma unroll
    for (int d0 = 0; d0 < 4; ++d0) qr[d0] = *(const bf16x8*)(Qw + d0 * 16);
    f32x16 o[4];
#pragma unroll
    for (int e = 0; e < 4; ++e) o[e] = f32x16{};
    float l_reg = 0.f;
    const int qpos = q0 + wq * 32 + r32;
    const int tband = (q0 - 112) >> 6;
    asm volatile("s_waitcnt vmcnt(0)" ::: "memory");
    __syncthreads();
    const float cfar = bt[128];
    int slot = 0;
    for (int t = 0; t < NT; ++t) {
        if (t > 0) { if (t + 1 < NT) asm volatile("s_waitcnt vmcnt(4)" ::: "memory"); else asm volatile("s_waitcnt vmcnt(0)" ::: "memory");
                     asm volatile("s_waitcnt lgkmcnt(0)\n\ts_barrier" ::: "memory"); }
        if (t + 2 < NT) { int s2 = slot + 2; if (s2 >= NSLOT) s2 -= NSLOT; DMA_TILE(t + 2, s2); }
        LAS unsigned char* Ks = shm + LDS_RING + slot * SLOT + KOFF;
        const int vbase = (int)(lds0 + LDS_RING + slot * SLOT + VOFF) + ((lane >> 4) & 1) * 32 + (lane & 3) * 8 + (4 * hi + ((lane & 15) >> 2)) * 64;
        const bool band = (t >= tband);
        f32x16 p0, p1;
        { const float ci = band ? 0.f : cfar;
#pragma unroll
          for (int r = 0; r < 16; ++r) { p0[r] = ci; p1[r] = ci; } }
        LAS unsigned char* kb = Ks + (cmap * 8 + hi) * 1024 + r32 * 16;
#pragma unroll
        for (int d0 = 0; d0 < 4; ++d0) {
            const bf16x8 k0 = *(const LAS bf16x8*)(kb + d0 * 2048), k1 = *(const LAS bf16x8*)(kb + d0 * 2048 + 512);
            p0 = __builtin_amdgcn_mfma_f32_32x32x16_bf16(k0, qr[d0], p0, 0, 0, 0);
            p1 = __builtin_amdgcn_mfma_f32_32x32x16_bf16(k1, qr[d0], p1, 0, 0, 0);
        }
        if (band) {
            const int nb = qpos - 64 * t - 4 * hi;
#pragma unroll
            for (int r = 0; r < 16; ++r) { const int n0 = nb - ((r & 3) + 8 * (r >> 2)); int i0 = n0 + 1, i1 = n0 - 31;
                i0 = i0 < 0 ? 0 : (i0 > 128 ? 128 : i0); i1 = i1 < 0 ? 0 : (i1 > 128 ? 128 : i1);
                p0[r] += bt[i0]; p1[r] += bt[i1]; }
        }
        float sacc = 0.f;
#pragma unroll
        for (int r = 0; r < 16; ++r) { p0[r] = __builtin_amdgcn_exp2f(p0[r]); p1[r] = __builtin_amdgcn_exp2f(p1[r]); sacc += p0[r] + p1[r]; }
        l_reg += sacc;
        u32x4 pw[4];
        pw[0] = (u32x4){cvtpk(p0[0], p0[1]), cvtpk(p0[2], p0[3]), cvtpk(p0[4], p0[5]), cvtpk(p0[6], p0[7])};
        pw[1] = (u32x4){cvtpk(p0[8], p0[9]), cvtpk(p0[10], p0[11]), cvtpk(p0[12], p0[13]), cvtpk(p0[14], p0[15])};
        pw[2] = (u32x4){cvtpk(p1[0], p1[1]), cvtpk(p1[2], p1[3]), cvtpk(p1[4], p1[5]), cvtpk(p1[6], p1[7])};
        pw[3] = (u32x4){cvtpk(p1[8], p1[9]), cvtpk(p1[10], p1[11]), cvtpk(p1[12], p1[13]), cvtpk(p1[14], p1[15])};
#pragma unroll
        for (int eb = 0; eb < 4; ++eb) {
            s16x4 lo[4], hi4[4];
#pragma unroll
            for (int ks = 0; ks < 4; ++ks) {
                asm volatile("ds_read_b64_tr_b16 %0,%1 offset:%c2" : "=&v"(lo[ks]) : "v"(vbase), "i"(eb * 4096 + ks * 1024) : "memory");
                asm volatile("ds_read_b64_tr_b16 %0,%1 offset:%c2" : "=&v"(hi4[ks]) : "v"(vbase), "i"(eb * 4096 + ks * 1024 + 512) : "memory");
            }
            asm volatile("s_waitcnt lgkmcnt(0)" ::: "memory"); __builtin_amdgcn_sched_barrier(0);
#pragma unroll
            for (int ks = 0; ks < 4; ++ks) {
                const bf16x8 vf = (bf16x8){lo[ks][0], lo[ks][1], lo[ks][2], lo[ks][3], hi4[ks][0], hi4[ks][1], hi4[ks][2], hi4[ks][3]};
                o[eb] = __builtin_amdgcn_mfma_f32_32x32x16_bf16(__builtin_bit_cast(bf16x8, pw[ks]), vf, o[eb], 0, 0, 0);
            }
        }
        slot = (slot + 1 == NSLOT) ? 0 : slot + 1;
    }
#undef DMA_TILE
    { auto rr = __builtin_amdgcn_permlane32_swap(__float_as_uint(l_reg), __float_as_uint(l_reg), false, false); l_reg = __uint_as_float(rr[0]) + __uint_as_float(rr[1]); }
    if (hi == 0) wsf[r32] = l_reg;
    asm volatile("s_waitcnt lgkmcnt(0)" ::: "memory");
    float rl[16];
#pragma unroll
    for (int r = 0; r < 16; ++r) rl[r] = __builtin_amdgcn_rcpf(wsf[crow(r, hi)]) * (cmap ? lam : 1.0f);
    asm volatile("s_waitcnt lgkmcnt(0)\n\ts_barrier" ::: "memory");
    LAS float* ex = (LAS float*)(shm + LDS_EX) + wq * 4096;
    if (cmap == 1) {
#pragma unroll
        for (int eb = 0; eb < 4; ++eb)
#pragma unroll
            for (int r = 0; r < 16; ++r) ex[(eb * 16 + r) * 64 + lane] = o[eb][r] * rl[r];
    }
    __syncthreads();
    if (cmap == 0) {
        float ssq[16];
#pragma unroll
        for (int r = 0; r < 16; ++r) ssq[r] = 0.f;
#pragma unroll
        for (int eb = 0; eb < 4; ++eb)
#pragma unroll
            for (int r = 0; r < 16; ++r) { const float v = o[eb][r] * rl[r] - ex[(eb * 16 + r) * 64 + lane]; o[eb][r] = v; ssq[r] += v * v; }
#pragma unroll
        for (int r = 0; r < 16; ++r) { float s = ssq[r]; s += __shfl_xor(s, 1); s += __shfl_xor(s, 2); s += __shfl_xor(s, 4); s += __shfl_xor(s, 8); s += __shfl_xor(s, 16);
            ssq[r] = rsqrtf(s * (1.0f / 128.0f) + EPS) * (1.0f - LAM_INIT); }
#pragma unroll
        for (int eb = 0; eb < 4; ++eb) { const float gsub = P.subln[eb * 32 + r32];
#pragma unroll
            for (int r = 0; r < 16; ++r) { const size_t off = (size_t)(rowbase + q0 + wq * 32 + crow(r, hi)) * DM + h * 128 + eb * 32 + r32;
                P.og[off] = f2bf(o[eb][r] * ssq[r] * gsub * bf2f(P.sz[off])); } }
    }
    __syncthreads();
}

__device__ __forceinline__ void attn_phase(const Params& P, LAS unsigned char* shm, int vcu, int G) {
    LAS float* misc = (LAS float*)(shm + LDS_MISC);
    if (threadIdx.x < 64) {
        const int l = threadIdx.x;
        float s1 = wave_sum(P.lq1[l] * P.lk1[l]), s2 = wave_sum(P.lq2[l] * P.lk2[l]);
        float mq = fabsf(P.gq[l]), mk = fabsf(P.gk[l]);
#pragma unroll
        for (int o = 1; o < 64; o <<= 1) { mq = fmaxf(mq, __shfl_xor(mq, o)); mk = fmaxf(mk, __shfl_xor(mk, o)); }
        if (l == 0) { misc[0] = expf(s1) - expf(s2) + LAM_INIT; misc[1] = 8.0f * mq * mk; }
    }
    __syncthreads();
    const float lam = misc[0], qkmax = misc[1];
    for (int U = vcu; U < 2048; U += G) {
        const int vv = U & 255, i = U >> 8, bh = vv >> 2, j = vv & 3;
        const int qb = (i & 1) ? (8 * (i >> 1) + 7 - j) : (8 * (i >> 1) + j);
        attn_unit(P, bh, qb, shm, lam, qkmax);
    }
}
}

namespace att2 {
using att::crow; using att::glds16; using att::t5_bucket; using att::Params;
constexpr int SLOTB = 16384, NSLOT = 3;
constexpr int LDS_K = 0, LDS_V = NSLOT * SLOTB, LDS_EX = 65536, LDS_BT = 131072, BT_STRIDE = 132, LDS_WSF = LDS_BT + 8 * BT_STRIDE * 4 + 128, LDS_MISC = LDS_WSF + 8 * 64 * 4, LDS_EXT = LDS_MISC + 128, LDS_TOTAL = LDS_EXT + 384 * 4;
typedef LAS const unsigned char* lds_cptr;
typedef short v4i16_t __attribute__((ext_vector_type(4)));
#define SBAR() __builtin_amdgcn_sched_barrier(0)
#define WAIT_BAR(N) asm volatile("s_waitcnt vmcnt(" #N ") lgkmcnt(0)\n\ts_barrier" ::: "memory")
__device__ __forceinline__ float rowsum32(float s) {
    s += __builtin_bit_cast(float, __builtin_amdgcn_update_dpp(0, __builtin_bit_cast(int, s), 0xB1, 0xF, 0xF, true));
    s += __builtin_bit_cast(float, __builtin_amdgcn_update_dpp(0, __builtin_bit_cast(int, s), 0x4E, 0xF, 0xF, true));
    s += __builtin_bit_cast(float, __builtin_amdgcn_update_dpp(0, __builtin_bit_cast(int, s), 0x141, 0xF, 0xF, true));
    s += __builtin_bit_cast(float, __builtin_amdgcn_update_dpp(0, __builtin_bit_cast(int, s), 0x140, 0xF, 0xF, true));
    auto rr = __builtin_amdgcn_permlane16_swap(__float_as_uint(s), __float_as_uint(s), false, false);
    return __uint_as_float(rr[0]) + __uint_as_float(rr[1]);
}
__device__ __forceinline__ s16x4 vtr(lds_cptr p) { return __builtin_bit_cast(s16x4, __builtin_amdgcn_ds_read_tr16_b64_v4i16((LAS v4i16_t*)p)); }
__device__ __forceinline__ void kload2(bf16x8* kf, lds_cptr kp, int j) { kf[2 * j] = *(const LAS bf16x8*)(kp + j * 2048); kf[2 * j + 1] = *(const LAS bf16x8*)(kp + j * 2048 + 512); }

__device__ __forceinline__ void attn_unit(const Params& P, int bh, int qb, LAS unsigned char* shm, float lam, bool first, bool has_next, int nbh, int nqb, bf16x8 (&qr)[4]) {
    const int tid = threadIdx.x, lane = tid & 63, r32 = lane & 31, hi = lane >> 5; const int wid = __builtin_amdgcn_readfirstlane(tid >> 6);
    const int cmap = wid >> 2, wq = wid & 3;
    const int b = bh >> 3, h = bh & 7; const long rowbase = (long)b * SEQ; const int q0 = qb * 128;
    const unsigned lds0 = (unsigned)(uintptr_t)shm;
    LAS float* bt = (LAS float*)(shm + LDS_BT) + h * BT_STRIDE;
    LAS float* wsf = (LAS float*)(shm + LDS_WSF) + wid * 64;
    const bf16_t* ksrc0 = P.k + (size_t)bh * 64 * 8192 + (2 * wid) * 512 + lane * 8; const bf16_t* ksrc1 = ksrc0 + 512;
    const bf16_t* vsrc0 = P.v + (size_t)bh * 64 * 8192 + (2 * wid) * 512 + lane * 8; const bf16_t* vsrc1 = vsrc0 + 512;
    const unsigned kdst = lds0 + LDS_K + (2 * wid) * 1024, vdst = lds0 + LDS_V + (2 * wid) * 1024;
    const int NT = 2 * qb + 2;
#define TCL(t) ((t) < NT ? (t) : NT - 1)
#define DMA_K0(t, slot) glds16(ksrc0 + (long)TCL(t) * 8192, (unsigned)__builtin_amdgcn_readfirstlane(kdst + (slot)))
#define DMA_K1(t, slot) glds16(ksrc1 + (long)TCL(t) * 8192, (unsigned)__builtin_amdgcn_readfirstlane(kdst + (slot) + 1024))
#define DMA_V0(t, slot) glds16(vsrc0 + (long)TCL(t) * 8192, (unsigned)__builtin_amdgcn_readfirstlane(vdst + (slot)))
#define DMA_V1(t, slot) glds16(vsrc1 + (long)TCL(t) * 8192, (unsigned)__builtin_amdgcn_readfirstlane(vdst + (slot) + 1024))
#define DMA_K(t, slot) do { DMA_K0(t, slot); DMA_K1(t, slot); } while (0)
#define DMA_V(t, slot) do { DMA_V0(t, slot); DMA_V1(t, slot); } while (0)
    if (first) { DMA_K(0, 0); DMA_V(0, 0); DMA_K(1, SLOTB); DMA_K(2, 2 * SLOTB); }
    if (first) { const bf16_t* Qw = P.q + (rowbase + q0 + wq * 32 + r32) * DM + h * 128 + cmap * 64 + hi * 8;
#pragma unroll
        for (int d0 = 0; d0 < 4; ++d0) qr[d0] = *(const bf16x8*)(Qw + d0 * 16); }
    f32x16 o[4];
#pragma unroll
    for (int e = 0; e < 4; ++e) o[e] = f32x16{};
    float l_reg = 0.f;
    const int qpos = q0 + wq * 32 + r32;
    const int tband = (q0 - 112) >> 6;
    const lds_cptr shm3 = (lds_cptr)shm;
    const lds_cptr kp0 = shm3 + LDS_K + (cmap * 8 + hi) * 1024 + r32 * 16;
    const lds_cptr vp0 = shm3 + LDS_V + ((lane >> 4) & 1) * 32 + (lane & 3) * 8 + (4 * hi + ((lane & 15) >> 2)) * 64;
    bf16x8 kf[8];
    LAS float* ext = (LAS float*)(shm + LDS_EXT);
    if (tid < 384) { int i_ = tid - 126; i_ = i_ < 0 ? 0 : (i_ > 128 ? 128 : i_); ext[tid] = bt[i_]; }
    asm volatile("s_waitcnt vmcnt(0) lgkmcnt(0)\n\ts_barrier" ::: "memory");
#define BAND(C0, C1, t) do { if ((t) >= tband) { const int nb_ = qpos - 64 * (t) - 4 * hi; \
        _Pragma("unroll") for (int r = 0; r < 16; ++r) { const int c_ = (r & 3) + 8 * (r >> 2); int j0_ = nb_ + 127 - c_, j1_ = nb_ + 95 - c_; \
            asm volatile("" : "+v"(j0_), "+v"(j1_)); C0[r] += ext[j0_]; C1[r] += ext[j1_]; } } } while (0)
    f32x16 pA0, pA1, pB0, pB1;
    { kload2(kf, kp0, 0); kload2(kf, kp0, 1); kload2(kf, kp0, 2); kload2(kf, kp0, 3);
      pA0 = f32x16{}; pA1 = f32x16{};
#pragma unroll
      for (int d0 = 0; d0 < 4; ++d0) { pA0 = __builtin_amdgcn_mfma_f32_32x32x16_bf16(kf[2 * d0], qr[d0], pA0, 0, 0, 0); pA1 = __builtin_amdgcn_mfma_f32_32x32x16_bf16(kf[2 * d0 + 1], qr[d0], pA1, 0, 0, 0); }
      BAND(pA0, pA1, 0);
#pragma unroll
      for (int r = 0; r < 16; ++r) { pA0[r] = __builtin_amdgcn_exp2f(pA0[r]); pA1[r] = __builtin_amdgcn_exp2f(pA1[r]); } }
    WAIT_BAR(0);
    DMA_K(3, 0); DMA_V(1, SLOTB);
    int sl_prev = 0, sl_cur = SLOTB, sl_next = 2 * SLOTB;
#define ROT() do { sl_prev = sl_cur; sl_cur = sl_next; sl_next = (sl_next == (NSLOT - 1) * SLOTB) ? 0 : sl_next + SLOTB; } while (0)
    kload2(kf, kp0 + sl_cur, 0); kload2(kf, kp0 + sl_cur, 1); kload2(kf, kp0 + sl_cur, 2); kload2(kf, kp0 + sl_cur, 3);
    WAIT_BAR(4);
    s16x4 vlo[8], vhi[8]; u32x4 pw0, pw1, pw2, pw3;
#define PKW(Pv, B) cvtpk(Pv[B], Pv[B + 1])
#define PAF(k) __builtin_bit_cast(bf16x8, pw##k)
#define VFR(i) (bf16x8){vlo[i][0], vlo[i][1], vlo[i][2], vlo[i][3], vhi[i][0], vhi[i][1], vhi[i][2], vhi[i][3]}
#define PIN(x) asm volatile("" : "+v"(x))
#define VRD(f) do { vlo[(f) & 7] = vtr(vp_ + (((f) & 3) * 4096 + ((f) >> 2) * 1024)); vhi[(f) & 7] = vtr(vp_ + (((f) & 3) * 4096 + ((f) >> 2) * 1024 + 512)); } while (0)
#define GAPA(MF, A0, A1, A2, A3, W0, W1, PW) do { MF; sacc += A0; sacc += A1; sacc += A2; sacc += A3; PIN(sacc); W0; W1; PIN(PW); SBAR(); } while (0)
#define EX(v) __builtin_amdgcn_exp2f(v)
#define GAPB(MF, X, B) do { MF; X[B] = EX(X[B]); X[B + 1] = EX(X[B + 1]); PIN(X); SBAR(); } while (0)
#define PVM(i, k) o[(i) & 3] = __builtin_amdgcn_mfma_f32_32x32x16_bf16(PAF(k), VFR((i) & 7), o[(i) & 3], 0, 0, 0)
#define STEP(C0, C1, P0, P1, t) do { SBAR(); \
    const lds_cptr vp_ = vp0 + sl_prev; const f32x16 zz_ = f32x16{}; \
    VRD(0); SBAR(); float sacc = (P0[0] + P0[1]); \
    GAPA(C0 = __builtin_amdgcn_mfma_f32_32x32x16_bf16(kf[0], qr[0], zz_, 0, 0, 0), P0[2], P0[3], P0[4], P0[5],     pw0[0] = PKW(P0, 0), pw0[1] = PKW(P0, 2), pw0); \
    VRD(1); SBAR(); GAPA(C1 = __builtin_amdgcn_mfma_f32_32x32x16_bf16(kf[1], qr[0], zz_, 0, 0, 0), P0[6], P0[7], P0[8], P0[9],     pw0[2] = PKW(P0, 4), pw0[3] = PKW(P0, 6), pw0); \
    VRD(2); SBAR(); GAPA(C0 = __builtin_amdgcn_mfma_f32_32x32x16_bf16(kf[2], qr[1], C0, 0, 0, 0),   P0[10], P0[11], P0[12], P0[13], pw1[0] = PKW(P0, 8), pw1[1] = PKW(P0, 10), pw1); \
    VRD(3); SBAR(); GAPA(C1 = __builtin_amdgcn_mfma_f32_32x32x16_bf16(kf[3], qr[1], C1, 0, 0, 0),   P0[14], P0[15], P1[0], P1[1],   pw1[2] = PKW(P0, 12), pw1[3] = PKW(P0, 14), pw1); \
    VRD(4); SBAR(); GAPA(C0 = __builtin_amdgcn_mfma_f32_32x32x16_bf16(kf[4], qr[2], C0, 0, 0, 0),   P1[2], P1[3], P1[4], P1[5],     pw2[0] = PKW(P1, 0), pw2[1] = PKW(P1, 2), pw2); \
    VRD(5); SBAR(); GAPA(C1 = __builtin_amdgcn_mfma_f32_32x32x16_bf16(kf[5], qr[2], C1, 0, 0, 0),   P1[6], P1[7], P1[8], P1[9],     pw2[2] = PKW(P1, 4), pw2[3] = PKW(P1, 6), pw2); \
    VRD(6); SBAR(); GAPA(C0 = __builtin_amdgcn_mfma_f32_32x32x16_bf16(kf[6], qr[3], C0, 0, 0, 0),   P1[10], P1[11], P1[12], P1[13], pw3[0] = PKW(P1, 8), pw3[1] = PKW(P1, 10), pw3); \
    VRD(7); SBAR(); GAPA(C1 = __builtin_amdgcn_mfma_f32_32x32x16_bf16(kf[7], qr[3], C1, 0, 0, 0),   P1[14], P1[15], 0.f, 0.f,       pw3[2] = PKW(P1, 12), pw3[3] = PKW(P1, 14), pw3); \
    l_reg += sacc; \
    BAND(C0, C1, t); \
    SBAR(); \
    GAPB(PVM(0, 0), C0, 0);   VRD(8);  SBAR(); \
    GAPB(PVM(1, 0), C0, 2);   VRD(9);  SBAR(); \
    GAPB(PVM(2, 0), C0, 4);   VRD(10); SBAR(); \
    GAPB(PVM(3, 0), C0, 6);   VRD(11); SBAR(); \
    GAPB(PVM(4, 1), C0, 8);   VRD(12); SBAR(); \
    GAPB(PVM(5, 1), C0, 10);  VRD(13); SBAR(); \
    GAPB(PVM(6, 1), C0, 12);  VRD(14); SBAR(); \
    GAPB(PVM(7, 1), C0, 14);  VRD(15); SBAR(); \
    GAPB(PVM(8, 2), C1, 0);   kload2(kf, kp0 + sl_next, 0); SBAR(); \
    GAPB(PVM(9, 2), C1, 2);   kload2(kf, kp0 + sl_next, 1); SBAR(); \
    GAPB(PVM(10, 2), C1, 4);  kload2(kf, kp0 + sl_next, 2); SBAR(); \
    GAPB(PVM(11, 2), C1, 6);  kload2(kf, kp0 + sl_next, 3); SBAR(); \
    GAPB(PVM(12, 3), C1, 8);  DMA_V0((t) + 1, sl_next); SBAR(); \
    GAPB(PVM(13, 3), C1, 10); DMA_V1((t) + 1, sl_next); SBAR(); \
    GAPB(PVM(14, 3), C1, 12); DMA_K0((t) + 3, sl_cur); SBAR(); \
    GAPB(PVM(15, 3), C1, 14); DMA_K1((t) + 3, sl_cur); SBAR(); \
    } while (0)
    int t = 1;
    for (; t + 1 < NT; t += 2) {
        STEP(pB0, pB1, pA0, pA1, t);     WAIT_BAR(4); ROT();
        STEP(pA0, pA1, pB0, pB1, t + 1); WAIT_BAR(4); ROT();
    }
    STEP(pB0, pB1, pA0, pA1, NT - 1); WAIT_BAR(4); ROT();
    { float sacc = pB0[0] + pB0[1];
#pragma unroll
      for (int r = 2; r < 16; ++r) sacc += pB0[r];
#pragma unroll
      for (int r = 0; r < 16; ++r) sacc += pB1[r];
      l_reg += sacc;
      pw0 = (u32x4){PKW(pB0, 0), PKW(pB0, 2), PKW(pB0, 4), PKW(pB0, 6)}; pw1 = (u32x4){PKW(pB0, 8), PKW(pB0, 10), PKW(pB0, 12), PKW(pB0, 14)};
      pw2 = (u32x4){PKW(pB1, 0), PKW(pB1, 2), PKW(pB1, 4), PKW(pB1, 6)}; pw3 = (u32x4){PKW(pB1, 8), PKW(pB1, 10), PKW(pB1, 12), PKW(pB1, 14)};
      const lds_cptr vp_ = vp0 + sl_prev;
      VRD(0); VRD(1); VRD(2); VRD(3); VRD(4); VRD(5); VRD(6); VRD(7);
      PVM(0, 0); PVM(1, 0); PVM(2, 0); PVM(3, 0); PVM(4, 1); PVM(5, 1); PVM(6, 1); PVM(7, 1);
      VRD(8); VRD(9); VRD(10); VRD(11); VRD(12); VRD(13); VRD(14); VRD(15);
      PVM(8, 2); PVM(9, 2); PVM(10, 2); PVM(11, 2); PVM(12, 3); PVM(13, 3); PVM(14, 3); PVM(15, 3); }
#undef STEP
#undef GAPA
#undef GAPB
#undef PVM
#undef VRD
#undef VFR
#undef PAF
#undef PKW
#undef PIN
#undef EX
#undef BAND
#undef DMA_K
#undef DMA_V
#undef DMA_K0
#undef DMA_K1
#undef DMA_V0
#undef DMA_V1
#undef TCL
#undef ROT
    { auto rr = __builtin_amdgcn_permlane32_swap(__float_as_uint(l_reg), __float_as_uint(l_reg), false, false); l_reg = __uint_as_float(rr[0]) + __uint_as_float(rr[1]); }
    if (hi == 0) wsf[r32] = l_reg;
    asm volatile("s_waitcnt lgkmcnt(0)" ::: "memory");
    float rl[16];
#pragma unroll
    for (int r = 0; r < 16; ++r) rl[r] = __builtin_amdgcn_rcpf(wsf[crow(r, hi)]) * (cmap ? lam : 1.0f);
    WAIT_BAR(0);
    const size_t gbase = (size_t)(rowbase + q0 + wq * 32) * DM + h * 128 + cmap * 64;
    u32x4 zq[4];
#pragma unroll
    for (int i = 0; i < 4; ++i) { const int pc = lane + 64 * i; zq[i] = __builtin_nontemporal_load((const u32x4*)(P.sz + gbase + (size_t)(pc >> 3) * DM + (pc & 7) * 8)); }
    if (has_next) {
        const int nt1 = (2 * nqb + 2 > 2) ? 2 : 1;
        const bf16_t* nk = P.k + (size_t)nbh * 64 * 8192 + (2 * wid) * 512 + lane * 8; const bf16_t* nv = P.v + (size_t)nbh * 64 * 8192 + (2 * wid) * 512 + lane * 8;
        glds16(nk, (unsigned)__builtin_amdgcn_readfirstlane(kdst)); glds16(nk + 512, (unsigned)__builtin_amdgcn_readfirstlane(kdst + 1024));
        glds16(nv, (unsigned)__builtin_amdgcn_readfirstlane(vdst)); glds16(nv + 512, (unsigned)__builtin_amdgcn_readfirstlane(vdst + 1024));
        glds16(nk + 8192, (unsigned)__builtin_amdgcn_readfirstlane(kdst + SLOTB)); glds16(nk + 8192 + 512, (unsigned)__builtin_amdgcn_readfirstlane(kdst + SLOTB + 1024));
        glds16(nk + (long)nt1 * 8192, (unsigned)__builtin_amdgcn_readfirstlane(kdst + 2 * SLOTB)); glds16(nk + (long)nt1 * 8192 + 512, (unsigned)__builtin_amdgcn_readfirstlane(kdst + 2 * SLOTB + 1024));
        const bf16_t* Qn = P.q + ((long)(nbh >> 3) * SEQ + nqb * 128 + wq * 32 + r32) * DM + (nbh & 7) * 128 + cmap * 64 + hi * 8;
#pragma unroll
        for (int d0 = 0; d0 < 4; ++d0) qr[d0] = *(const bf16x8*)(Qn + d0 * 16);
    }
    LAS float* ex = (LAS float*)(shm + LDS_EX) + wq * 4096;
    {
        LAS float* exs = ex + cmap * 2048;
#pragma unroll
        for (int e2 = 0; e2 < 2; ++e2)
#pragma unroll
            for (int r = 0; r < 16; ++r) exs[(e2 * 16 + r) * 64 + lane] = (cmap ? o[e2][r] : o[2 + e2][r]) * rl[r];
    }
    asm volatile("s_waitcnt lgkmcnt(0)\n\ts_barrier" ::: "memory");
    float vk[2][16], ssq[16];
    {   const LAS float* exr = ex + (cmap ^ 1) * 2048;
#pragma unroll
        for (int r = 0; r < 16; ++r) ssq[r] = 0.f;
#pragma unroll
        for (int e2 = 0; e2 < 2; ++e2)
#pragma unroll
            for (int r = 0; r < 16; ++r) { const float mine = (cmap ? o[2 + e2][r] : o[e2][r]) * rl[r], oth = exr[(e2 * 16 + r) * 64 + lane];
                const float v = cmap ? oth - mine : mine - oth; vk[e2][r] = v; ssq[r] += v * v; }
    }
#pragma unroll
    for (int r = 0; r < 16; ++r) ssq[r] = rowsum32(ssq[r]);
    if (r32 == 0) {
#pragma unroll
        for (int r = 0; r < 16; ++r) wsf[hi * 16 + r] = ssq[r];
    }
    asm volatile("s_waitcnt lgkmcnt(0)\n\ts_barrier" ::: "memory");
    { const LAS float* wsp = (const LAS float*)(shm + LDS_WSF) + (wid ^ 4) * 64 + hi * 16;
#pragma unroll
      for (int r = 0; r < 16; ++r) ssq[r] = rsqrtf((ssq[r] + wsp[r]) * (1.0f / 128.0f) + EPS) * (1.0f - LAM_INIT); }
#pragma unroll
    for (int e2 = 0; e2 < 2; ++e2) { const float gsub = P.subln[cmap * 64 + e2 * 32 + r32];
#pragma unroll
        for (int r = 0; r < 16; ++r) ex[crow(r, hi) * 128 + cmap * 64 + e2 * 32 + r32] = vk[e2][r] * ssq[r] * gsub; }
    asm volatile("s_waitcnt lgkmcnt(0)" ::: "memory");
#pragma unroll
    for (int i = 0; i < 4; ++i) { const int pc = lane + 64 * i; const LAS f32x4* sp = (const LAS f32x4*)(ex + (pc >> 3) * 128 + cmap * 64 + (pc & 7) * 8);
        f32x4 z0, z1; unpack8(zq[i], z0, z1);
        *(u32x4*)(P.og + gbase + (size_t)(pc >> 3) * DM + (pc & 7) * 8) = pack8(sp[0] * z0, sp[1] * z1); }
}
#undef SBAR
#undef WAIT_BAR

__device__ __forceinline__ void unit_of(int U, int vcu, int G, int& bh, int& qb) {
    if (G == 256) {
        const int k = U >> 8, x = vcu >> 5, c = vcu & 31; bh = x * 8 + k;
        qb = (k & 1) ? 31 - ((c + 4 * (k - 1)) & 31) : ((c + 4 * k) & 31);
    } else { bh = U >> 5; qb = U & 31; }
}
__device__ __forceinline__ void attn_tables(const Params& P, LAS unsigned char* shm) {
    LAS float* misc = (LAS float*)(shm + LDS_MISC);
    if (threadIdx.x < 64) {
        const int l = threadIdx.x;
        const float s1 = wave_sum(P.lq1[l] * P.lk1[l]), s2 = wave_sum(P.lq2[l] * P.lk2[l]);
        if (l == 0) misc[0] = expf(s1) - expf(s2) + LAM_INIT;
    }
    for (int e = threadIdx.x; e < 8 * 129; e += 512) { const int hh = e / 129, i = e - hh * 129, n = i - 1;
        ((LAS float*)(shm + LDS_BT))[hh * BT_STRIDE + i] = (i == 0) ? -INFINITY : (P.rel_bias[t5_bucket(n) * NH + hh] - P.rel_bias[31 * NH + hh]) * LOG2E; }
}
__device__ __forceinline__ void attn_phase(const Params& P, LAS unsigned char* shm, int vcu, int G, bool tables_ready) {
    LAS float* misc = (LAS float*)(shm + LDS_MISC);
    if (!tables_ready) {
    if (threadIdx.x < 64) {
        const int l = threadIdx.x;
        const float s1 = wave_sum(P.lq1[l] * P.lk1[l]), s2 = wave_sum(P.lq2[l] * P.lk2[l]);
        if (l == 0) misc[0] = expf(s1) - expf(s2) + LAM_INIT;
    }
    for (int e = threadIdx.x; e < 8 * 129; e += 512) { const int hh = e / 129, i = e - hh * 129, n = i - 1;
        ((LAS float*)(shm + LDS_BT))[hh * BT_STRIDE + i] = (i == 0) ? -INFINITY : (P.rel_bias[t5_bucket(n) * NH + hh] - P.rel_bias[31 * NH + hh]) * LOG2E; }
    }
    __syncthreads();
    const float lam = misc[0];
    bool first = true; bf16x8 qr[4];
#pragma unroll
    for (int d0 = 0; d0 < 4; ++d0) qr[d0] = bf16x8{};
    if (__builtin_amdgcn_readfirstlane((int)(threadIdx.x >> 6)) >= 4) __builtin_amdgcn_s_setprio(1);
    for (int U = vcu; U < 2048; U += G) {
        int bh, qb, nbh = 0, nqb = 0; unit_of(U, vcu, G, bh, qb);
        const bool has_next = (U + G < 2048); if (has_next) unit_of(U + G, vcu, G, nbh, nqb);
        attn_unit(P, bh, qb, shm, lam, first, has_next, nbh, nqb, qr); first = false;
    }
    __builtin_amdgcn_s_setprio(0);
}
}

struct Args { const float* in[30]; float* out; unsigned char* ws; int ph_lo, ph_hi; };

constexpr int LDS_BYTES = 147456;

__device__ __forceinline__ void transpose_item(const float* W, int ldsrc, int scol0, const float* gain, bf16_t* WT, int K, int nrow0, int k0, LAS float* scr, int lane) {
    float wv[32];
#pragma unroll
    for (int i = 0; i < 32; ++i) wv[i] = W[(size_t)(k0 + 2 * i + (lane >> 5)) * ldsrc + scol0 + (lane & 31)];
#pragma unroll
    for (int i = 0; i < 32; ++i) { const int kk = 2 * i + (lane >> 5); float v = wv[i]; if (gain) v *= gain[k0 + kk]; scr[kk * 33 + (lane & 31)] = v; }
    asm volatile("s_waitcnt lgkmcnt(0)" ::: "memory");
    const int c = lane & 7;
#pragma unroll
    for (int j = 0; j < 4; ++j) { const int n = (lane >> 3) + 8 * j; const LAS float* s = scr + (8 * c) * 33 + n;
        u32x4 o; o.x = cvtpk(s[0 * 33], s[1 * 33]); o.y = cvtpk(s[2 * 33], s[3 * 33]); o.z = cvtpk(s[4 * 33], s[5 * 33]); o.w = cvtpk(s[6 * 33], s[7 * 33]);
        *(u32x4*)(WT + (size_t)(nrow0 + n) * K + k0 + 8 * c) = o; }
    asm volatile("s_waitcnt lgkmcnt(0)" ::: "memory");
}
__device__ __forceinline__ void cpow(float lr, float li, float dt, float n, float& re, float& im) { const float mag = __expf(lr * dt * n), ang = li * dt * n; re = mag * __cosf(ang); im = mag * __sinf(ang); }
__device__ __forceinline__ void zoh_f(float lr, float li, float dt, float& fr_, float& fi_) {
    const float x = lr * dt, y = li * dt, ex = __expf(x), sh = __sinf(0.5f * y);
    const float nr = expm1f(x) * __cosf(y) - 2.0f * sh * sh, ni = ex * __sinf(y), den = lr * lr + li * li;
    fr_ = (nr * lr + ni * li) / den; fi_ = (ni * lr - nr * li) / den;
}

__device__ __forceinline__ void prologue(const Args& a, LAS unsigned char* lds, int vcu, int G) {
    const int tid = threadIdx.x, lane = tid & 63, wave = __builtin_amdgcn_readfirstlane(tid >> 6);
    const int gw = vcu * 8 + wave, NGW = G * 8;
    unsigned char* ws = a.ws;
    const float *lam_re = a.in[4], *lam_im = a.in[5], *log_dt = a.in[6], *b_re = a.in[7], *b_im = a.in[8], *c_re = a.in[9], *c_im = a.in[10], *dvec = a.in[11];
    bf16_t* bts = (bf16_t*)(ws + WS_BTS); bf16_t* w1s = (bf16_t*)(ws + WS_W1S);
    constexpr int N_D3 = NG * TC, N_D1 = NG * TC, N_D2 = NG * TC, N_D4 = NG * TC, N_D5 = 64, TG = TC * GC, N_X = M / 8;
    constexpr int T_IN0 = 16 * 64, T_GLU = 16 * 64, T_SQ = 16 * 32, T_PRJ = 4 * 32, T_QKV = 16 * 128;
    constexpr int N_T = T_IN0 + T_GLU + 4 * T_SQ + 2 * T_PRJ + T_QKV;
    constexpr int O_D1 = N_D3, O_D2 = O_D1 + N_D1, O_D4 = O_D2 + N_D2, O_D5 = O_D4 + N_D4, O_T = O_D5 + N_D5, O_X = O_T + N_T, N_ALL = O_X + N_X;
    LAS float* scr = (LAS float*)(lds + wave * 16384);
    static_assert(N_ALL == 229 * 64, "item blocks");
    for (int it0 = gw; it0 < N_ALL; it0 += NGW) {
        const int it = ((((it0 >> 6) * 89) % 229) << 6) | (it0 & 63);
        if (it < O_D1) {
            const int g = it / TC, tau = it % TC; const float dt = __expf(log_dt[g]);
            { f32x4 ld[16];
              const f32x4* s0 = (const f32x4*)(c_re + (size_t)g * GC * NP) + lane; const f32x4* s1 = (const f32x4*)(c_im + (size_t)g * GC * NP) + lane;
              const f32x4* s2 = (const f32x4*)(b_re + (size_t)g * NP * GC) + lane; const f32x4* s3 = (const f32x4*)(b_im + (size_t)g * NP * GC) + lane;
#pragma unroll
              for (int i = 0; i < 4; ++i) { ld[i] = s0[64 * i]; ld[4 + i] = s1[64 * i]; ld[8 + i] = s2[64 * i]; ld[12 + i] = s3[64 * i]; }
#pragma unroll
              for (int a = 0; a < 4; ++a)
#pragma unroll
                for (int i = 0; i < 4; ++i) *(LAS f32x4*)(scr + a * 1024 + (lane + 64 * i) * 4) = ld[4 * a + i]; }
            float Gr, Gi;
            { const int p = lane; const float lr = lam_re[g * NP + p], li = lam_im[g * NP + p];
              float f_r, f_i, ar, ai; zoh_f(lr, li, dt, f_r, f_i); cpow(lr, li, dt, (float)tau, ar, ai);
              Gr = ar * f_r - ai * f_i; Gi = ar * f_i + ai * f_r; }
            asm volatile("s_waitcnt lgkmcnt(0)" ::: "memory");
            const int c = lane >> 2, q4 = (lane & 3) * 4;
            f32x4 kt = (f32x4){0.f, 0.f, 0.f, 0.f};
#pragma unroll
            for (int p0 = 0; p0 < NP; p0 += 4) {
                const f32x4 cr4 = *(const LAS f32x4*)(scr + c * NP + p0), ci4 = *(const LAS f32x4*)(scr + 1024 + c * NP + p0);
#pragma unroll
                for (int pp = 0; pp < 4; ++pp) { const int p = p0 + pp;
                    const float gr = __builtin_bit_cast(float, __builtin_amdgcn_readlane(__builtin_bit_cast(int, Gr), p)), gi = __builtin_bit_cast(float, __builtin_amdgcn_readlane(__builtin_bit_cast(int, Gi), p));
                    const float er = cr4[pp] * gr - ci4[pp] * gi, ei = cr4[pp] * gi + ci4[pp] * gr;
                    const f32x4 br = *(const LAS f32x4*)(scr + 2048 + p * GC + q4), bi = *(const LAS f32x4*)(scr + 3072 + p * GC + q4);
                    kt += er * br - ei * bi; }
            }
            if (tau == 0) {
#pragma unroll
                for (int j = 0; j < 4; ++j) if (q4 + j == c) kt[j] += dvec[g * GC + c];
            }
            const u32x2 w = (u32x2){cvtpk(kt[0], kt[1]), cvtpk(kt[2], kt[3])};
            for (int s = 0; s + tau < TC; ++s) *(u32x2*)(bts + ((size_t)g * TG + (s + tau) * GC + c) * KX + 128 + s * GC + q4) = w;
            asm volatile("s_waitcnt lgkmcnt(0)" ::: "memory");
        } else if (it < O_D2) {
            const int r = it - O_D1, g = r / TC, s = r % TC, p = lane; const float dt = __expf(log_dt[g]);
            const float lr = lam_re[g * NP + p], li = lam_im[g * NP + p];
            float f_r, f_i, ar, ai; zoh_f(lr, li, dt, f_r, f_i); cpow(lr, li, dt, (float)(TC - 1 - s), ar, ai);
            const float gr = ar * f_r - ai * f_i, gi = ar * f_i + ai * f_r;
            const float* br = b_re + (size_t)(g * NP + p) * GC; const float* bi = b_im + (size_t)(g * NP + p) * GC;
            float vr[16], vi[16];
#pragma unroll
            for (int j = 0; j < 16; ++j) { vr[j] = gr * br[j] - gi * bi[j]; vi[j] = gr * bi[j] + gi * br[j]; }
            bf16_t* dr = w1s + ((size_t)g * 128 + p) * TG + s * GC; bf16_t* di = dr + (size_t)64 * TG;
            *(u32x4*)dr = (u32x4){cvtpk(vr[0], vr[1]), cvtpk(vr[2], vr[3]), cvtpk(vr[4], vr[5]), cvtpk(vr[6], vr[7])};
            *(u32x4*)(dr + 8) = (u32x4){cvtpk(vr[8], vr[9]), cvtpk(vr[10], vr[11]), cvtpk(vr[12], vr[13]), cvtpk(vr[14], vr[15])};
            *(u32x4*)di = (u32x4){cvtpk(vi[0], vi[1]), cvtpk(vi[2], vi[3]), cvtpk(vi[4], vi[5]), cvtpk(vi[6], vi[7])};
            *(u32x4*)(di + 8) = (u32x4){cvtpk(vi[8], vi[9]), cvtpk(vi[10], vi[11]), cvtpk(vi[12], vi[13]), cvtpk(vi[14], vi[15])};
        } else if (it < O_D4) {
            const int r = it - O_D2, g = r / TC, t = r % TC, p = lane; const float dt = __expf(log_dt[g]);
            const float lr = lam_re[g * NP + p], li = lam_im[g * NP + p];
            float ar, ai; cpow(lr, li, dt, (float)(t + 1), ar, ai);
            float crv[GC], civ[GC];
#pragma unroll
            for (int c = 0; c < GC; ++c) { crv[c] = c_re[(g * GC + c) * NP + p]; civ[c] = c_im[(g * GC + c) * NP + p]; }
#pragma unroll
            for (int c = 0; c < GC; ++c) { const float cr = crv[c], ci = civ[c];
                bf16_t* d = bts + ((size_t)g * TG + t * GC + c) * KX; d[p] = f2bf(cr * ar - ci * ai); d[64 + p] = f2bf(-(cr * ai + ci * ar)); }
        } else if (it < O_D5) {
            const int r = it - O_D4, g = r / TC, t = r % TC; const int npc = (TC - 1 - t) * 2;
            for (int idx = lane; idx < GC * npc; idx += 64) { const int c = idx / npc, pc = idx - c * npc;
                *(u32x4*)(bts + ((size_t)g * TG + t * GC + c) * KX + 128 + (t + 1) * GC + pc * 8) = (u32x4){0u, 0u, 0u, 0u}; }
        } else if (it < O_T) {
            const int g = it - O_D5, p = lane; float ar, ai; cpow(lam_re[g * NP + p], lam_im[g * NP + p], __expf(log_dt[g]), (float)TC, ar, ai);
            float* at = (float*)(ws + WS_AT); at[(g * NP + p) * 2] = ar; at[(g * NP + p) * 2 + 1] = ai;
        } else if (it < O_X) {
            int r = it - O_T;
            if (r < T_IN0) { const int kb = r >> 6, nb = r & 63; transpose_item(a.in[3], 2048, 32 * nb, a.in[2], (bf16_t*)(ws + WS_W_IN0), 1024, 32 * nb, 64 * kb, scr, lane); continue; } r -= T_IN0;
            if (r < T_GLU) { const int kb = r >> 6, nb = r & 63, n0 = 32 * nb; transpose_item(a.in[12], 2048, ((n0 >> 7) & 1) * 1024 + 128 * (n0 >> 8) + (n0 & 127), nullptr, (bf16_t*)(ws + WS_W_GLU), 1024, n0, 64 * kb, scr, lane); continue; } r -= T_GLU;
            if (r < T_SQ) { transpose_item(a.in[13], 1024, 32 * (r & 31), nullptr, (bf16_t*)(ws + WS_W_OUT0), 1024, 32 * (r & 31), 64 * (r >> 5), scr, lane); continue; } r -= T_SQ;
            if (r < T_SQ) { transpose_item(a.in[29], 1024, 32 * (r & 31), nullptr, (bf16_t*)(ws + WS_W_GATE0), 1024, 32 * (r & 31), 64 * (r >> 5), scr, lane); continue; } r -= T_SQ;
            if (r < T_SQ) { transpose_item(a.in[26], 1024, 32 * (r & 31), nullptr, (bf16_t*)(ws + WS_W_OUT1), 1024, 32 * (r & 31), 64 * (r >> 5), scr, lane); continue; } r -= T_SQ;
            if (r < T_SQ) { transpose_item(a.in[29] + (size_t)DM * DM, 1024, 32 * (r & 31), nullptr, (bf16_t*)(ws + WS_W_GATE1), 1024, 32 * (r & 31), 64 * (r >> 5), scr, lane); continue; } r -= T_SQ;
            if (r < T_PRJ) { transpose_item(a.in[28], 1024, 32 * (r & 31), nullptr, (bf16_t*)(ws + WS_W_PROJ0), 256, 32 * (r & 31), 64 * (r >> 5), scr, lane); continue; } r -= T_PRJ;
            if (r < T_PRJ) { transpose_item(a.in[28] + (size_t)PLE * DM, 1024, 32 * (r & 31), nullptr, (bf16_t*)(ws + WS_W_PROJ1), 256, 32 * (r & 31), 64 * (r >> 5), scr, lane); continue; } r -= T_PRJ;
            { const int kb = r >> 7, nb = r & 127, n0 = 32 * nb, type = n0 >> 10, within = n0 & 1023;
              const int scol = 256 * (within >> 8) + 64 * ((within >> 5) & 3) + 32 * ((within >> 7) & 1);
              const float* src = type == 0 ? a.in[15] : (type == 1 ? a.in[16] : a.in[19]); const int ld = type < 2 ? 1024 : 2048;
              const float* gain = type < 2 ? a.in[14] : a.in[18];
              transpose_item(src, ld, scol + (type == 3 ? 1024 : 0), gain, (bf16_t*)(ws + WS_W_QKV), 1024, n0, 64 * kb, scr, lane); }
        } else {
            const int r0 = (it - O_X) * 8; float* ss0 = (float*)(ws + WS_SS0); bf16_t* xb = (bf16_t*)(ws + WS_XB);
            f32x4 v[8][2][2];
#pragma unroll
            for (int rr = 0; rr < 8; ++rr)
#pragma unroll
                for (int j = 0; j < 2; ++j) { const f32x4* xr = (const f32x4*)(a.in[0] + (size_t)(r0 + rr) * DM + (lane + 64 * j) * 8);
                    v[rr][j][0] = __builtin_nontemporal_load(xr); v[rr][j][1] = __builtin_nontemporal_load(xr + 1); }
#pragma unroll
            for (int rr = 0; rr < 8; ++rr) { const int row = r0 + rr; float s = 0.f;
#pragma unroll
                for (int j = 0; j < 2; ++j) { s += sumsq4(v[rr][j][0]) + sumsq4(v[rr][j][1]); *(u32x4*)(xb + (size_t)row * DM + (lane + 64 * j) * 8) = pack8(v[rr][j][0], v[rr][j][1]); }
                s = wave_sum(s); if (lane == 0) ss0[row] = s; }
        }
    }
}

__device__ __forceinline__ void convert_p(const float* p, bf16_t* pb, int layer, bool xl, int XI, int KR, int vcu, int G) {
    const int lane = threadIdx.x & 63, wave = __builtin_amdgcn_readfirstlane(threadIdx.x >> 6);
    const int first = xl ? XI * 256 + KR * 8 + wave : vcu * 8 + wave, step = xl ? 2048 : G * 8, lim = xl ? XI * 256 + 256 : 2048;
    for (int it = first; it < lim; it += step) {
        const size_t e0 = (size_t)layer * M * PLE + (size_t)it * 4096; const float* sp = p + e0; bf16_t* dp = pb + e0;
        f32x4 v[8][2];
#pragma unroll
        for (int j = 0; j < 8; ++j) { const f32x4* q = (const f32x4*)(sp + (lane + 64 * j) * 8); v[j][0] = __builtin_nontemporal_load(q); v[j][1] = __builtin_nontemporal_load(q + 1); }
#pragma unroll
        for (int j = 0; j < 8; ++j) *(u32x4*)(dp + (lane + 64 * j) * 8) = pack8(v[j][0], v[j][1]);
    }
}

__device__ __forceinline__ void ssm_state_phase(const bf16_t* aext, const bf16_t* w1s, float* S, int vcu, int G) {
    const int lane = threadIdx.x & 63, r32 = lane & 31, hi = lane >> 5, w = __builtin_amdgcn_readfirstlane(threadIdx.x >> 6);
    for (int unit = vcu; unit < 512; unit += G) {
        const int g = unit >> 3, cb = (unit & 7) * 256 + w * 32;
        const bf16_t* arow = aext + ((size_t)(g * NCHUNK + cb + r32)) * KX + 128 + 8 * hi;
        const bf16_t* brow = w1s + ((size_t)g * 128 + r32) * (TC * GC) + 8 * hi;
        f32x16 acc[4];
#pragma unroll
        for (int n = 0; n < 4; ++n) acc[n] = f32x16{};
#pragma unroll 8
        for (int kk = 0; kk < TC * GC / 16; ++kk) {
            const bf16x8 av = *(const bf16x8*)(arow + 16 * kk);
#pragma unroll
            for (int n = 0; n < 4; ++n) { const bf16x8 bv = *(const bf16x8*)(brow + (size_t)n * 32 * (TC * GC) + 16 * kk); acc[n] = __builtin_amdgcn_mfma_f32_32x32x16_bf16(av, bv, acc[n], 0, 0, 0); }
        }
#pragma unroll
        for (int n = 0; n < 4; ++n)
#pragma unroll
            for (int r = 0; r < 16; ++r) S[((size_t)(g * NCHUNK + cb + att::crow(r, hi))) * 128 + n * 32 + r32] = acc[n][r];
    }
}
__device__ __forceinline__ void ssm_scan_phase(const float* S, const float* at, bf16_t* aext, int vcu, int G) {
    const int tid = threadIdx.x;
    if (tid >= 128) return;
    for (int item = vcu; item < 256; item += G) {
        const int idx = item * 128 + tid, p = idx & 63, g = (idx >> 6) & 63, b = idx >> 12;
        const float ar = at[(g * NP + p) * 2], ai = at[(g * NP + p) * 2 + 1]; float hr = 0.f, hi_ = 0.f;
        const size_t base0 = (size_t)g * NCHUNK + (size_t)b * NCK;
        for (int ck0 = 0; ck0 < NCK; ck0 += 32) {
            float sr[32], si[32];
#pragma unroll
            for (int i = 0; i < 32; ++i) { sr[i] = S[(base0 + ck0 + i) * 128 + p]; si[i] = S[(base0 + ck0 + i) * 128 + 64 + p]; }
#pragma unroll
            for (int i = 0; i < 32; ++i) {
                aext[(base0 + ck0 + i) * KX + p] = f2bf(hr); aext[(base0 + ck0 + i) * KX + 64 + p] = f2bf(hi_);
                const float nr = ar * hr - ai * hi_ + sr[i], ni = ar * hi_ + ai * hr + si[i]; hr = nr; hi_ = ni;
            }
        }
    }
}


__device__ __forceinline__ void ssm_state_scan_fused(const bf16_t* aext_c, const bf16_t* w1s, const float* at, bf16_t* aext, LAS unsigned char* lds, int vcu, bool xl, int XI, int KR) {
    const int tid = threadIdx.x, lane = tid & 63, r32 = lane & 31, hi = lane >> 5, w = __builtin_amdgcn_readfirstlane(tid >> 6);
    LAS float* Sl = (LAS float*)lds;
    LAS float* Eb = (LAS float*)(lds + 256 * 129 * 4);
#pragma unroll 1
    for (int ui = 0; ui < 2; ++ui) {
        const int L = vcu + 256 * ui, g = xl ? KR * 2 + ui : L >> 3, cb0 = (xl ? XI : (L & 7)) * NCK;
        {
            const bf16_t* wg = w1s + (size_t)g * 128 * (TC * GC);
#pragma unroll
            for (int j = 0; j < 8; ++j) { const int q = j * 512 + tid, row = q >> 5, kg = (q & 31) ^ (row & 31);
                __builtin_amdgcn_global_load_lds((const unsigned*)(wg + (size_t)row * (TC * GC) + kg * 8), (LAS unsigned*)(lds + j * 8192 + w * 1024), 16, 0, 0); }
            const int cb = cb0 + w * 32;
            const bf16_t* arow = aext_c + ((size_t)(g * NCHUNK + cb + r32)) * KX + 128 + 8 * hi;
            f32x16 acc[4];
#pragma unroll
            for (int n = 0; n < 4; ++n) acc[n] = f32x16{};
            asm volatile("s_waitcnt vmcnt(0)" ::: "memory");
            __syncthreads();
#pragma unroll 8
            for (int kk = 0; kk < TC * GC / 16; ++kk) {
                const bf16x8 av = *(const bf16x8*)(arow + 16 * kk);
#pragma unroll
                for (int n = 0; n < 4; ++n) { const bf16x8 bv = *(const LAS bf16x8*)(lds + ((n * 32 + r32) * 32 + ((2 * kk + hi) ^ r32)) * 16); acc[n] = __builtin_amdgcn_mfma_f32_32x32x16_bf16(av, bv, acc[n], 0, 0, 0); }
            }
            __syncthreads();
#pragma unroll
            for (int n = 0; n < 4; ++n)
#pragma unroll
                for (int r = 0; r < 16; ++r) Sl[(w * 32 + att::crow(r, hi)) * 129 + n * 32 + r32] = acc[n][r];
        }
        __syncthreads();
        const int p = tid & 63, seg = __builtin_amdgcn_readfirstlane(tid >> 6);
        float ar = 0.f, ai = 0.f;
        LAS float* sp = Sl + (seg * 64) * 129 + p;
        if (tid < 256) {
            ar = at[(g * NP + p) * 2]; ai = at[(g * NP + p) * 2 + 1]; float hr = 0.f, hi_ = 0.f;
#pragma unroll 8
            for (int ck = 0; ck < 64; ++ck) { const float sr = sp[ck * 129], si = sp[ck * 129 + 64]; const float nr = ar * hr - ai * hi_ + sr, ni = ar * hi_ + ai * hr + si; hr = nr; hi_ = ni; }
            Eb[(seg * 64 + p) * 2] = hr; Eb[(seg * 64 + p) * 2 + 1] = hi_;
        }
        __syncthreads();
        if (tid < 256) {
            float qr = ar, qi = ai;
#pragma unroll
            for (int k = 0; k < 6; ++k) { const float nr = qr * qr - qi * qi, ni = 2.f * qr * qi; qr = nr; qi = ni; }
            float hr = 0.f, hi_ = 0.f;
            for (int sg = 0; sg < seg; ++sg) { const float er = Eb[(sg * 64 + p) * 2], ei = Eb[(sg * 64 + p) * 2 + 1]; const float nr = qr * hr - qi * hi_ + er, ni = qr * hi_ + qi * hr + ei; hr = nr; hi_ = ni; }
#pragma unroll 8
            for (int ck = 0; ck < 64; ++ck) {
                const float sr = sp[ck * 129], si = sp[ck * 129 + 64];
                ((LAS unsigned*)sp)[ck * 129] = (unsigned)f2bf(hr) | ((unsigned)f2bf(hi_) << 16);
                const float nr = ar * hr - ai * hi_ + sr, ni = ar * hi_ + ai * hr + si; hr = nr; hi_ = ni;
            }
        }
        __syncthreads();
        {
            for (int pc = tid; pc < 256 * 16; pc += 512) { const int row = pc >> 4, j = pc & 15, isim = j >> 3, p0 = (j & 7) * 8;
                const LAS unsigned* wp = (const LAS unsigned*)Sl + row * 129 + p0;
                unsigned v[8];
#pragma unroll
                for (int e = 0; e < 8; ++e) v[e] = isim ? (wp[e] >> 16) : (wp[e] & 0xffffu);
                u32x4 o; o.x = v[0] | (v[1] << 16); o.y = v[2] | (v[3] << 16); o.z = v[4] | (v[5] << 16); o.w = v[6] | (v[7] << 16);
                *(u32x4*)(aext + ((size_t)g * NCHUNK + cb0 + row) * KX + isim * 64 + p0) = o; }
            asm volatile("s_waitcnt vmcnt(0)" ::: "memory");
        }
        __syncthreads();
    }
}

#ifndef USE_CG_SYNC
#define USE_CG_SYNC 0
#endif
#define XB_TMO      128
#define XB_XCNT(j)  (256  + 64 * (j))
#define XB_XSUB(j)  (1280 + 64 * (j))
#define XB_XGEN(j)  (2304 + 64 * (j))
#define XB_TOP      3328
#define XB_TOPGEN   3392
#define XCD_BAR_WORDS 3456
#define XB_SPIN_CAP (1u << 20)
__device__ __forceinline__ unsigned xb_ld(unsigned* p)              { return __hip_atomic_load(p, __ATOMIC_RELAXED, __HIP_MEMORY_SCOPE_AGENT); }
__device__ __forceinline__ unsigned xb_add(unsigned* p, unsigned v) { return __hip_atomic_fetch_add(p, v, __ATOMIC_RELAXED, __HIP_MEMORY_SCOPE_AGENT); }
__device__ __forceinline__ unsigned xb_xcc_id() { return (unsigned)__builtin_amdgcn_s_getreg((3 << 11) | 20) & 0xFu; }
#define XB_SPIN(cond, bar) do { unsigned _sp = 0; while (cond) { __builtin_amdgcn_s_sleep(1); \
    if ((++_sp & 255u) == 0u) { if (xb_ld(&(bar)[XB_TMO])) break; if (_sp > XB_SPIN_CAP) { atomicAdd(&(bar)[XB_TMO], 1u); break; } } } } while (0)
struct XcdBarrier { unsigned* bar; unsigned x; volatile LAS unsigned* st; };
__device__ __forceinline__ XcdBarrier xcd_barrier_post(unsigned* bar, volatile LAS unsigned* st) {
    XcdBarrier b; b.bar = bar; b.x = xb_xcc_id(); b.st = st;
    if (threadIdx.x == 0) st[2] = xb_add(&bar[XB_XCNT(b.x)], 1u);
    return b;
}
__device__ __forceinline__ void xcd_barrier_complete(unsigned* bar, unsigned x, unsigned& nloc, unsigned& nx) {
    const unsigned G = gridDim.x * gridDim.y * gridDim.z;
    unsigned sum, cnt, mine, sp = 0u;
    for (;;) {
        sum = 0u; cnt = 0u; mine = 0u;
#pragma unroll
        for (unsigned j = 0; j < 16; ++j) { const unsigned c = xb_ld(&bar[XB_XCNT(j)]); sum += c; cnt += (c > 0u) ? 1u : 0u; mine = (j == x) ? c : mine; }
        if (sum == G) break;
        __builtin_amdgcn_s_sleep(1);
        if ((++sp & 255u) == 0u) { if (xb_ld(&bar[XB_TMO])) break; if (sp > XB_SPIN_CAP) { atomicAdd(&bar[XB_TMO], 1u); break; } }
    }
    nloc = mine > 0u ? mine : 1u; nx = cnt > 0u ? cnt : 1u;
}
__device__ __forceinline__ void xcd_census_shape(unsigned* bar, unsigned x, unsigned& xidx, unsigned& regular) {
    unsigned idx = 0u, npop = 0u, ok = 1u;
#pragma unroll
    for (unsigned j = 0; j < 16; ++j) { const unsigned c = xb_ld(&bar[XB_XCNT(j)]); if (c > 0u) { npop++; if (j < x) idx++; if (c != 32u) ok = 0u; } }
    xidx = idx; regular = (ok && npop == 8u) ? 1u : 0u;
}
__device__ __forceinline__ void xcd_barrier(const XcdBarrier& b, bool local_only = false) {
    asm volatile("s_waitcnt vmcnt(0)" ::: "memory");
    __syncthreads();
    if (threadIdx.x == 0) {
        unsigned* bar = b.bar;
        __builtin_amdgcn_s_waitcnt(0);
        unsigned nloc = b.st[0], nx = b.st[1];
        if (nloc == 0u) { xcd_barrier_complete(bar, b.x, nloc, nx); unsigned xi, rg; xcd_census_shape(bar, b.x, xi, rg); b.st[3] = xi; b.st[4] = rg; b.st[0] = nloc; b.st[1] = nx; }
        const unsigned old = xb_add(&bar[XB_XSUB(b.x)], 1u);
        const unsigned gen = old / nloc;
        if (old + 1u == (gen + 1u) * nloc) {
            if (!local_only) {
            __builtin_amdgcn_fence(__ATOMIC_RELEASE, "agent");
            asm volatile("s_waitcnt vmcnt(0)" ::: "memory");
            const unsigned og = xb_add(&bar[XB_TOP], 1u);
            const unsigned tg = og / nx;
            if (og + 1u == (tg + 1u) * nx) xb_add(&bar[XB_TOPGEN], 1u);
            else XB_SPIN(xb_ld(&bar[XB_TOPGEN]) == tg, bar);
            }
            __builtin_amdgcn_fence(__ATOMIC_ACQUIRE, "agent");
            xb_add(&bar[XB_XGEN(b.x)], 1u);
            asm volatile("s_waitcnt vmcnt(0)" ::: "memory");
        } else {
            XB_SPIN(xb_ld(&bar[XB_XGEN(b.x)]) == gen, bar);
            __builtin_amdgcn_fence(__ATOMIC_ACQUIRE, "agent");
            asm volatile("s_waitcnt vmcnt(0)" ::: "memory");
        }
    }
    __syncthreads();
}
__device__ __forceinline__ void xcd_barrier_local_arrive(const XcdBarrier& b) {
    asm volatile("s_waitcnt vmcnt(0)" ::: "memory");
    __syncthreads();
    if (threadIdx.x == 0) {
        unsigned* bar = b.bar;
        __builtin_amdgcn_s_waitcnt(0);
        const unsigned nloc = b.st[0];
        const unsigned old = xb_add(&bar[XB_XSUB(b.x)], 1u);
        const unsigned gen = old / nloc;
        if (old + 1u == (gen + 1u) * nloc) { xb_add(&bar[XB_XGEN(b.x)], 1u); b.st[5] = 0xffffffffu; }
        else b.st[5] = gen;
    }
}
__device__ __forceinline__ void xcd_barrier_local_wait(const XcdBarrier& b) {
    if (threadIdx.x == 0) {
        unsigned* bar = b.bar;
        const unsigned gen = b.st[5];
        if (gen != 0xffffffffu) XB_SPIN(xb_ld(&bar[XB_XGEN(b.x)]) == gen, bar);
        __builtin_amdgcn_fence(__ATOMIC_ACQUIRE, "agent");
        asm volatile("s_waitcnt vmcnt(0)" ::: "memory");
    }
    __syncthreads();
}
constexpr int LDS_XB_OFF = 140 * 1024;
constexpr size_t CTL_ZERO_BYTES = 65536;

__global__ void __launch_bounds__(512, 2) fwd_kernel(Args args) {
    extern __shared__ __attribute__((aligned(16))) unsigned char lds_raw[];
    LAS unsigned char* lds = (LAS unsigned char*)lds_raw;
    const int G = gridDim.x, bx = blockIdx.x;
    const int vcu = (G % 8 == 0) ? (bx % 8) * (G / 8) + bx / 8 : bx;
    unsigned char* ws = args.ws;
    const int lo = args.ph_lo, hi = args.ph_hi;
#define IN(k) (lo <= (k) && (k) < hi)
#if USE_CG_SYNC
#define SEAM(k) do { if (IN(k) && IN((k) + 1)) { cg::this_grid().sync(); } } while (0)
#else
    XcdBarrier bar; bar.bar = (unsigned*)ws + 1024; bar.x = 0; bar.st = nullptr;
    if (hi - lo > 1) {
        volatile LAS unsigned* st = (volatile LAS unsigned*)(lds + LDS_XB_OFF);
        if (threadIdx.x < 8) st[threadIdx.x] = 0u;
        __syncthreads();
        bar = xcd_barrier_post((unsigned*)ws + 1024, st);
    }
#define SEAM(k) do { if (IN(k) && IN((k) + 1)) { xcd_barrier(bar); } } while (0)
#endif
    float* xs = args.out;
    if (IN(0)) { prologue(args, lds, vcu, G); }
    SEAM(0);
#if !USE_CG_SYNC
    const bool xl = (hi - lo > 1) && lo == 0 && hi >= 12 && G == 256 && __builtin_amdgcn_readfirstlane((int)bar.st[4]) != 0;
    const int XI = xl ? __builtin_amdgcn_readfirstlane((int)bar.st[3]) : 0, KR = xl ? (__builtin_amdgcn_readfirstlane((int)bar.st[2]) & 31) : 0;
#define SEAMX(k) do { if (IN(k) && IN((k) + 1)) { xcd_barrier(bar, xl); } } while (0)
#else
    const bool xl = false; const int XI = 0, KR = 0;
#define SEAMX(k) SEAM(k)
#endif
    if (IN(1)) {
        { pg8::Gemm g{(const bf16_t*)(ws + WS_XB), (const bf16_t*)(ws + WS_W_IN0), DM, DM}; pg8::DualOrder S; S.init(M, 2048, DM, G, bx, xl, XI, KR);
          const LAS float* rl_ = nullptr; if (xl) { pg8::row_scales1_to_lds((const float*)(ws + WS_SS0), 16 * XI + (KR & 7), (LAS float*)(lds + pg8::LDS_RS_OFF)); rl_ = (const LAS float*)(lds + pg8::LDS_RS_OFF); }
          pg8::EpiInProj E{(const float*)(ws + WS_SS0), (bf16_t*)(ws + WS_AEXT), (bf16_t*)(ws + WS_SZ0), rl_};
          pg8::gemm_phase<pg8::EpiInProj, pg8::DualOrder, true>(lds, g, S, E); }
    }
    SEAMX(1);
    const bool ssm_fused = (G == 256) && IN(2) && IN(3) && IN(4);
    if (ssm_fused) ssm_state_scan_fused((const bf16_t*)(ws + WS_AEXT), (const bf16_t*)(ws + WS_W1S), (const float*)(ws + WS_AT), (bf16_t*)(ws + WS_AEXT), lds, vcu, xl, XI, KR);
    else {
    if (IN(2)) ssm_state_phase((const bf16_t*)(ws + WS_AEXT), (const bf16_t*)(ws + WS_W1S), (float*)(ws + WS_S), vcu, G);
    SEAM(2);
    if (IN(3)) ssm_scan_phase((const float*)(ws + WS_S), (const float*)(ws + WS_AT), (bf16_t*)(ws + WS_AEXT), vcu, G);
    SEAM(3);
    }
    if (IN(4)) { pg8::Gemm g{(const bf16_t*)(ws + WS_AEXT), (const bf16_t*)(ws + WS_BTS), KX, KX}; pg8::SsmOrder S{G, vcu, xl, XI, KR};
        pg8::EpiY E{(bf16_t*)(ws + WS_YB)}; pg8::gemm_phase<pg8::EpiY, pg8::SsmOrder, true>(lds, g, S, E); }
    if (xl && IN(4) && IN(5)) { xcd_barrier_local_arrive(bar); convert_p(args.in[1], (bf16_t*)(ws + WS_PB), 0, xl, XI, KR, vcu, G); xcd_barrier_local_wait(bar); }
    else { SEAMX(4); if (IN(5)) convert_p(args.in[1], (bf16_t*)(ws + WS_PB), 0, xl, XI, KR, vcu, G); }
    if (IN(5)) { pg8::Gemm g{(const bf16_t*)(ws + WS_YB), (const bf16_t*)(ws + WS_W_GLU), M, DM}; pg8::DualOrder S; S.init(M, 2048, DM, G, bx, xl, XI, KR);
        pg8::EpiGlu E{(const bf16_t*)(ws + WS_SZ0), (bf16_t*)(ws + WS_GB)}; pg8::gemm_phase<pg8::EpiGlu, pg8::DualOrder, true, 1>(lds, g, S, E); }
    SEAMX(5);
    const bool pflip = xl && (XI & 1);
    if (IN(6) && (pflip || !xl)) { pg8::Gemm g{(const bf16_t*)(ws + WS_PB), (const bf16_t*)(ws + WS_W_PROJ0), PLE, PLE}; pg8::DualOrder S; S.init(M, DM, PLE, G, bx, xl, XI, KR);
        pg8::EpiStore E{(bf16_t*)(ws + WS_PP0)}; pg8::gemm_phase<pg8::EpiStore, pg8::DualOrder, true>(lds, g, S, E); }
    if (IN(6)) { pg8::Gemm g{(const bf16_t*)(ws + WS_GB), (const bf16_t*)(ws + WS_W_OUT0), DM, DM}; pg8::DualOrder S; S.init(M, DM, DM, G, bx, xl, XI, KR);
        pg8::EpiOutRes<true, false> E{nullptr, (const bf16_t*)(ws + WS_XB), (bf16_t*)(ws + WS_X1B), (float*)(ws + WS_SSP1)}; pg8::gemm_phase<pg8::EpiOutRes<true, false>, pg8::DualOrder, true, 3>(lds, g, S, E); }
    if (IN(6) && xl && !pflip) { pg8::Gemm g{(const bf16_t*)(ws + WS_PB), (const bf16_t*)(ws + WS_W_PROJ0), PLE, PLE}; pg8::DualOrder S; S.init(M, DM, PLE, G, bx, xl, XI, KR);
        pg8::EpiStore E{(bf16_t*)(ws + WS_PP0)}; pg8::gemm_phase<pg8::EpiStore, pg8::DualOrder, true>(lds, g, S, E); }
    SEAMX(6);
    if (IN(7)) { pg8::Gemm g{(const bf16_t*)(ws + WS_X1B), (const bf16_t*)(ws + WS_W_GATE0), DM, DM}; pg8::DualOrder S; S.init(M, DM, DM, G, bx, xl, XI, KR);
        const LAS float* rl_ = nullptr; if (xl) { pg8::row_scales_to_lds((const float*)(ws + WS_SSP1), 16 * XI + (KR & 7), (LAS float*)(lds + pg8::LDS_RS_OFF)); rl_ = (const LAS float*)(lds + pg8::LDS_RS_OFF); }
        pg8::EpiGate<false> E{(const bf16_t*)(ws + WS_X1B), (const bf16_t*)(ws + WS_PP0), (const float*)(ws + WS_SSP1), (bf16_t*)(ws + WS_X2B), (float*)(ws + WS_SSP2), nullptr, rl_};
        pg8::gemm_phase<pg8::EpiGate<false>, pg8::DualOrder, true, 3>(lds, g, S, E); }
    SEAMX(7);
    if (IN(8)) { pg8::Gemm g{(const bf16_t*)(ws + WS_X2B), (const bf16_t*)(ws + WS_W_QKV), DM, DM}; pg8::DualOrder S; S.init(M, 4096, DM, G, bx, xl, XI, KR);
        const LAS float* rl_ = nullptr; if (xl) { pg8::row_scales_to_lds((const float*)(ws + WS_SSP2), 16 * XI + (KR & 7), (LAS float*)(lds + pg8::LDS_RS_OFF)); rl_ = (const LAS float*)(lds + pg8::LDS_RS_OFF); }
        pg8::EpiQKV E{(const float*)(ws + WS_SSP2), args.in[17], args.in[20], (bf16_t*)(ws + WS_K), (bf16_t*)(ws + WS_V), (bf16_t*)(ws + WS_Q), (bf16_t*)(ws + WS_SZ1), 0.125f * LOG2E, rl_};
        pg8::gemm_phase<pg8::EpiQKV, pg8::DualOrder, true, 3>(lds, g, S, E); }
    const att::Params AP{(const bf16_t*)(ws + WS_Q), (const bf16_t*)(ws + WS_K), (const bf16_t*)(ws + WS_V), (const bf16_t*)(ws + WS_SZ1), (bf16_t*)(ws + WS_OG),
                         args.in[27], args.in[20], args.in[17], args.in[21], args.in[22], args.in[23], args.in[24], args.in[25]};
    const bool attn_pre = xl && IN(8) && IN(9);
    if (attn_pre) { xcd_barrier_local_arrive(bar); convert_p(args.in[1], (bf16_t*)(ws + WS_PB), 1, xl, XI, KR, vcu, G); att2::attn_tables(AP, lds); xcd_barrier_local_wait(bar); }
    else { SEAMX(8); if (IN(9)) convert_p(args.in[1], (bf16_t*)(ws + WS_PB), 1, xl, XI, KR, vcu, G); }
    if (IN(9)) att2::attn_phase(AP, lds, xl ? XI * 32 + KR : vcu, G, attn_pre);
    SEAMX(9);
    if (IN(10) && (pflip || !xl)) { pg8::Gemm g{(const bf16_t*)(ws + WS_PB) + (size_t)M * PLE, (const bf16_t*)(ws + WS_W_PROJ1), PLE, PLE}; pg8::DualOrder S; S.init(M, DM, PLE, G, bx, xl, XI, KR);
        pg8::EpiStore E{(bf16_t*)(ws + WS_PP1)}; pg8::gemm_phase<pg8::EpiStore, pg8::DualOrder, true>(lds, g, S, E); }
    if (IN(10)) { pg8::Gemm g{(const bf16_t*)(ws + WS_OG), (const bf16_t*)(ws + WS_W_OUT1), DM, DM}; pg8::DualOrder S; S.init(M, DM, DM, G, bx, xl, XI, KR);
        pg8::EpiOutRes<true> E{nullptr, (const bf16_t*)(ws + WS_X2B), (bf16_t*)(ws + WS_X3B), (float*)(ws + WS_SSP3)}; pg8::gemm_phase<pg8::EpiOutRes<true>, pg8::DualOrder, true>(lds, g, S, E); }
    if (IN(10) && xl && !pflip) { pg8::Gemm g{(const bf16_t*)(ws + WS_PB) + (size_t)M * PLE, (const bf16_t*)(ws + WS_W_PROJ1), PLE, PLE}; pg8::DualOrder S; S.init(M, DM, PLE, G, bx, xl, XI, KR);
        pg8::EpiStore E{(bf16_t*)(ws + WS_PP1)}; pg8::gemm_phase<pg8::EpiStore, pg8::DualOrder, true>(lds, g, S, E); }
    SEAMX(10);
    if (IN(11)) { pg8::Gemm g{(const bf16_t*)(ws + WS_X3B), (const bf16_t*)(ws + WS_W_GATE1), DM, DM}; pg8::DualOrder S; S.init(M, DM, DM, G, bx, xl, XI, KR);
        const LAS float* rl_ = nullptr; if (xl) { pg8::row_scales_to_lds((const float*)(ws + WS_SSP3), 16 * XI + (KR & 7), (LAS float*)(lds + pg8::LDS_RS_OFF)); rl_ = (const LAS float*)(lds + pg8::LDS_RS_OFF); }
        pg8::EpiGate<true> E{(const bf16_t*)(ws + WS_X3B), (const bf16_t*)(ws + WS_PP1), (const float*)(ws + WS_SSP3), nullptr, nullptr, xs, rl_};
        pg8::gemm_phase<pg8::EpiGate<true>, pg8::DualOrder, true, 3>(lds, g, S, E); }
#undef SEAMX
#undef IN
#undef SEAM
}

extern "C" void kernel_launch(void* const* d_in, const int* in_sizes, int n_in, void* d_out, int out_size, void* d_ws, size_t ws_size, hipStream_t stream) {
    static int grid = 0;
    if (grid == 0) {
        if (n_in != 30 || in_sizes[0] != M * DM || out_size != M * DM || ws_size < WS_END) { fprintf(stderr, "kernel_launch: unexpected shapes (n_in %d, in0 %d, out %d, ws %zu)\n", n_in, n_in > 0 ? in_sizes[0] : -1, out_size, ws_size); grid = -1; return; }
        int dev = 0, cus = 0, per_cu = 0;
        if (hipGetDevice(&dev) != hipSuccess || hipDeviceGetAttribute(&cus, hipDeviceAttributeMultiprocessorCount, dev) != hipSuccess) { grid = -1; return; }
        if (hipFuncSetAttribute((const void*)fwd_kernel, hipFuncAttributeMaxDynamicSharedMemorySize, LDS_BYTES) != hipSuccess) { fprintf(stderr, "kernel_launch: hipFuncSetAttribute failed\n"); grid = -1; return; }
        if (hipOccupancyMaxActiveBlocksPerMultiprocessor(&per_cu, (const void*)fwd_kernel, 512, LDS_BYTES) != hipSuccess || per_cu < 1) { fprintf(stderr, "kernel_launch: occupancy query failed (%d)\n", per_cu); (void)hipGetLastError(); grid = -1; return; }
        grid = cus * 1;
        fprintf(stderr, "kernel_launch: grid %d (cus %d, per_cu %d)\n", grid, cus, per_cu);
    }
    if (grid < 0) return;
    Args a{};
    for (int i = 0; i < 30; ++i) a.in[i] = (const float*)d_in[i];
    a.out = (float*)d_out; a.ws = (unsigned char*)d_ws;
#if MK_N_LAUNCHES == 1
    a.ph_lo = 0; a.ph_hi = 12;
#if !USE_CG_SYNC
    if (hipMemsetAsync(d_ws, 0, CTL_ZERO_BYTES, stream) != hipSuccess) { fprintf(stderr, "kernel_launch: hipMemsetAsync failed\n"); return; }
#endif
    void* kargs[] = {&a};
    hipError_t e = hipLaunchCooperativeKernel((const void*)fwd_kernel, dim3(grid), dim3(512), kargs, LDS_BYTES, stream);
    if (e != hipSuccess) fprintf(stderr, "kernel_launch: cooperative launch failed: %s (grid %d)\n", hipGetErrorString(e), grid);
#else
    for (int ph = 0; ph < 12; ++ph) { a.ph_lo = ph; a.ph_hi = ph + 1;
        for (int rep = 0; rep < 1 + ((PROBE_MASK >> ph) & 1); ++rep) hipLaunchKernelGGL(fwd_kernel, dim3(grid), dim3(512), LDS_BYTES, stream, a); }
#endif
}
```

```cpp
#include <hip/hip_runtime.h>
#include <hip/hip_cooperative_groups.h>
#include <cstdio>
#include <cstdint>
#include <cmath>
namespace cg = cooperative_groups;

#ifndef MK_N_LAUNCHES
#define MK_N_LAUNCHES 1
#endif

#ifndef PROBE_MASK
#define PROBE_MASK 0
#endif

#define LAS __attribute__((address_space(3)))
typedef unsigned short bf16_t;
typedef short bf16x8 __attribute__((ext_vector_type(8)));
typedef short s16x4 __attribute__((ext_vector_type(4)));
typedef float f32x2 __attribute__((ext_vector_type(2)));
typedef float f32x4 __attribute__((ext_vector_type(4)));
typedef float f32x16 __attribute__((ext_vector_type(16)));
typedef unsigned u32x2 __attribute__((ext_vector_type(2)));
typedef unsigned u32x4 __attribute__((ext_vector_type(4)));
typedef __bf16 bf16x2_t __attribute__((ext_vector_type(2)));

constexpr int BATCH = 8, SEQ = 4096, DM = 1024, M = BATCH * SEQ, PLE = 256;
constexpr int NG = 64, GC = 16, NP = 64, TC = 16, NCK = SEQ / TC, NCHUNK = BATCH * NCK;
constexpr int KX = 128 + TC * GC;
constexpr int NH = 8;
constexpr float EPS = 1e-6f;
constexpr float LOG2E = 1.4426950408889634f;
constexpr float LAM_INIT = 0.35550906759096926f;

constexpr size_t MiB = 1u << 20;
constexpr size_t WS_SS0 = 1 * MiB, WS_SSP1 = 2 * MiB, WS_SSP2 = 4 * MiB, WS_SSP3 = 6 * MiB, WS_AT = 8 * MiB;
constexpr size_t WS_W_IN0 = 9 * MiB, WS_W_GLU = 13 * MiB, WS_W_OUT0 = 17 * MiB, WS_W_GATE0 = 19 * MiB, WS_W_QKV = 21 * MiB, WS_W_OUT1 = 29 * MiB, WS_W_GATE1 = 31 * MiB,
                 WS_W_PROJ0 = 33 * MiB, WS_W_PROJ1 = 33 * MiB + 512 * 1024;
constexpr size_t WS_R1 = 34 * MiB, WS_R2 = 98 * MiB, WS_R3 = 162 * MiB, WS_R4 = 226 * MiB, WS_R5 = 290 * MiB, WS_R6 = 370 * MiB, WS_R7 = 402 * MiB, WS_R8 = 466 * MiB, WS_END = 498 * MiB;
constexpr size_t WS_PP1 = WS_R1, WS_PP0 = WS_R2, WS_K = WS_R2, WS_XB = WS_R1, WS_YB = WS_R3, WS_X1B = WS_R3, WS_Q = WS_R3, WS_OG = WS_R3, WS_X3B = WS_R5,
                 WS_SZ0 = WS_R4, WS_X2B = WS_R4, WS_AEXT = WS_R5, WS_GB = WS_R5, WS_V = WS_R5, WS_PB = WS_R8, WS_S = WS_R2,
                 WS_W1S = WS_R7, WS_BTS = WS_R7 + 8 * MiB, WS_SZ1 = WS_R7;

__device__ __forceinline__ float sum_fq(float s) {
    auto a = __builtin_amdgcn_permlane32_swap(__builtin_bit_cast(unsigned, s), __builtin_bit_cast(unsigned, s), false, false);
    s = __builtin_bit_cast(float, (unsigned)a[0]) + __builtin_bit_cast(float, (unsigned)a[1]);
    auto b = __builtin_amdgcn_permlane16_swap(__builtin_bit_cast(unsigned, s), __builtin_bit_cast(unsigned, s), false, false);
    return __builtin_bit_cast(float, (unsigned)b[0]) + __builtin_bit_cast(float, (unsigned)b[1]);
}
__device__ __forceinline__ size_t ln_off(int row, int col) {
    const int tile = (row >> 8) * 4 + (col >> 8), rl = row & 255, cl = col & 255;
    const int wid = ((rl >> 6) & 1) * 4 + ((cl >> 5) & 3), piece = (rl >> 7) * 8 + ((rl >> 4) & 3) * 2 + (cl >> 7), ln = ((cl >> 3) & 3) * 16 + (rl & 15);
    return (((size_t)tile * 8 + wid) * 16 + piece) * 512 + (size_t)ln * 8 + (cl & 7);
}
__device__ __forceinline__ unsigned cvtpk(float lo, float hi) { f32x2 v = {lo, hi}; bf16x2_t b = __builtin_convertvector(v, bf16x2_t); return __builtin_bit_cast(unsigned, b); }
__device__ __forceinline__ bf16_t f2bf(float f) { unsigned u = __builtin_bit_cast(unsigned, f); return (bf16_t)((u + 0x7fffu + ((u >> 16) & 1u)) >> 16); }
__device__ __forceinline__ float bf2f(unsigned short b) { return __builtin_bit_cast(float, (unsigned)b << 16); }
__device__ __forceinline__ float bflo(unsigned w) { return __builtin_bit_cast(float, w << 16); }
__device__ __forceinline__ float bfhi(unsigned w) { return __builtin_bit_cast(float, w & 0xffff0000u); }
__device__ __forceinline__ u32x4 pack8(f32x4 a, f32x4 b) { u32x4 w; w.x = cvtpk(a[0], a[1]); w.y = cvtpk(a[2], a[3]); w.z = cvtpk(b[0], b[1]); w.w = cvtpk(b[2], b[3]); return w; }
__device__ __forceinline__ void unpack8(u32x4 w, f32x4& a, f32x4& b) { a = (f32x4){bflo(w.x), bfhi(w.x), bflo(w.y), bfhi(w.y)}; b = (f32x4){bflo(w.z), bfhi(w.z), bflo(w.w), bfhi(w.w)}; }
__device__ __forceinline__ float sigmoidf_(float x) { return __builtin_amdgcn_rcpf(1.0f + __builtin_amdgcn_exp2f(-LOG2E * x)); }
__device__ __forceinline__ float siluf_(float x) { return x * sigmoidf_(x); }
__device__ __forceinline__ float gelu_tanh(float x) { const float t = x + 0.044715f * x * x * x; return x * __builtin_amdgcn_rcpf(1.0f + __builtin_amdgcn_exp2f(-2.302208198f * t)); }
__device__ __forceinline__ f32x4 sig4(f32x4 v) { return (f32x4){sigmoidf_(v[0]), sigmoidf_(v[1]), sigmoidf_(v[2]), sigmoidf_(v[3])}; }
__device__ __forceinline__ f32x4 silu4(f32x4 v) { return (f32x4){siluf_(v[0]), siluf_(v[1]), siluf_(v[2]), siluf_(v[3])}; }
__device__ __forceinline__ f32x4 gelu4(f32x4 v) { return (f32x4){gelu_tanh(v[0]), gelu_tanh(v[1]), gelu_tanh(v[2]), gelu_tanh(v[3])}; }
__device__ __forceinline__ float sumsq4(f32x4 v) { return (v[0] * v[0] + v[1] * v[1]) + (v[2] * v[2] + v[3] * v[3]); }
__device__ __forceinline__ float wave_sum(float v) {
    v += __builtin_bit_cast(float, __builtin_amdgcn_update_dpp(0, __builtin_bit_cast(int, v), 0xB1, 0xF, 0xF, true));
    v += __builtin_bit_cast(float, __builtin_amdgcn_update_dpp(0, __builtin_bit_cast(int, v), 0x4E, 0xF, 0xF, true));
    v += __builtin_bit_cast(float, __builtin_amdgcn_update_dpp(0, __builtin_bit_cast(int, v), 0x141, 0xF, 0xF, true));
    v += __builtin_bit_cast(float, __builtin_amdgcn_update_dpp(0, __builtin_bit_cast(int, v), 0x140, 0xF, 0xF, true));
    return sum_fq(v);
}

namespace pg8 {
constexpr int BM = 256, BK = 64, HALF = 128, HTB = HALF * BK * 2, STAGE_BYTES = 8 * HTB, NXCD = 8, WGM = 8;
__host__ __device__ __forceinline__ int lds_byte(int r, int c) { const int st = (r >> 4) * 2 + (c >> 5), rr = r & 15, cc = c & 31, ob = rr * 64 + cc * 2; return st * 1024 + (ob ^ (((ob >> 9) & 1) << 5)); }
__host__ __device__ __forceinline__ void stage_rc(int b, int& R, int& C) { const int st = b / 1024, sb = b % 1024, swz = sb ^ (((sb >> 9) & 1) << 5); R = (st >> 1) * 16 + swz / 64; C = (st & 1) * 32 + (swz % 64) / 2; }
__host__ __device__ __forceinline__ int perm32(int rho) { const int n = rho >> 4, i = rho & 15; return 8 * (i >> 2) + 4 * n + (i & 3); }

struct Unit { int pm, pn, nt; };
struct Gemm { const bf16_t* A; const bf16_t* Bt; int lda, ldb; };

struct StaticOrder {
    int nM, nN, nwg, G, c, nt;
    __device__ void init(int M_, int N_, int K_, int G_, int c_) { nM = M_ / BM; nN = N_ / BM; nwg = nM * nN; G = G_; c = c_; nt = K_ / BK; }
    __device__ bool next(int i, Unit& u) const {
        const long L = (long)i * G + c; if (L >= nwg) return false;
        int wgid = (int)L; { const int q = nwg / NXCD, r = nwg % NXCD, xcd = wgid % NXCD, off = wgid / NXCD; wgid = (xcd < r ? xcd * (q + 1) : r * (q + 1) + (xcd - r) * q) + off; }
        const int nig = WGM * nN, gid = wgid / nig, fm = gid * WGM, gsz = (nM - fm) < WGM ? (nM - fm) : WGM;
        u.pm = fm + ((wgid % nig) % gsz); u.pn = (wgid % nig) / gsz; u.nt = nt; return true;
    }
};
struct DualOrder {
    StaticOrder so; bool xl; int X, k, nrounds;
    __device__ void init(int M_, int N_, int K_, int G_, int c_, bool xl_, int X_, int k_) { so.init(M_, N_, K_, G_, c_); xl = xl_; X = X_; k = k_; nrounds = N_ / BM / 2; }
    __device__ bool next(int i, Unit& u) const {
        if (!xl) return so.next(i, u);
        if (i >= nrounds) return false;
        u.pm = 16 * X + (k & 7) + 8 * (i & 1); u.pn = (k >> 3) + 4 * (i >> 1); u.nt = so.nt; return true;
    }
};
struct SsmOrder {
    int G, v; bool xl; int XI, KR;
    __device__ bool next(int i, Unit& u) const {
        int g, b;
        if (xl) { if (i >= 2) return false; g = KR * 2 + i; b = XI; }
        else { const int L = i * G + v; if (L >= 512) return false; g = L >> 3; b = L & 7; }
        int nt = KX / BK; asm volatile("" : "+s"(nt));
        u.pm = g * 8 + b; u.pn = g; u.nt = nt; return true;
    }
};

template <class Epi, class Sched, bool ALIGN_EPI, int AMODE = 0>
__device__ __forceinline__ void gemm_phase(LAS unsigned char* lds, const Gemm g, const Sched& S, const Epi& E) {
    int tid = threadIdx.x; asm volatile("" : "+v"(tid));
    const int wid = __builtin_amdgcn_readfirstlane(tid >> 6), lane = tid & 63, wr = wid >> 2, wc = wid & 3, fr = lane & 15, fq = lane >> 4;
    unsigned voffA[2], voffB[2];
#pragma unroll
    for (int i = 0; i < 2; ++i) { int R, C; stage_rc(tid * 16 + i * 8192, R, C); const int Rb = Epi::PERM ? ((R & ~31) + perm32(R & 31)) : R;
        voffA[i] = AMODE == 1 ? (unsigned)(((C >> 4) * g.lda + R) * 16 + (C & 15)) * 2u
                 : (AMODE == 3 ? (unsigned)(((((R >> 6) & 1) * 4 + ((C >> 5) & 1)) * 16 + ((R >> 4) & 3) * 2) * 1024 + (tid & 63) * 16) : (unsigned)(R * g.lda + C) * 2u);
        voffB[i] = (unsigned)(Rb * g.ldb + C) * 2u; }
    const size_t kstep = (size_t)(BK * 2), kstepA = AMODE == 1 ? (size_t)(BK / 16) * g.lda * 32 : kstep;
    auto AK = [&](int kt) -> size_t { if constexpr (AMODE == 3) return (size_t)(kt >> 2) * 131072 + (size_t)(kt & 1) * 32768 + (size_t)((kt >> 1) & 1) * 1024; else return (size_t)kt * kstepA; };
    const size_t hstepA = AMODE == 1 ? (size_t)HALF * 32 : (AMODE == 3 ? (size_t)8192 : (size_t)HALF * g.lda * 2), hstepB = (size_t)HALF * g.ldb * 2;
    const size_t tstepA = AMODE == 3 ? (size_t)524288 : 2 * hstepA, tstepB = 2 * hstepB;
    const unsigned ldsw = (unsigned)wid * 1024u;
    const int aoff = AMODE == 3 ? wr * 8192 + lane * 16 : lds_byte(wr * 64 + fr, fq * 8), boff = lds_byte(wc * 32 + fr, fq * 8);
#define PG8_SA(b, h) (((b) * 2 + (h)) * HTB)
#define PG8_SB(b, h) ((4 + (b) * 2 + (h)) * HTB)
#define PG8_STAGE(bufoff, gbase, voff) do { _Pragma("unroll") for (int _i = 0; _i < 2; ++_i) \
        __builtin_amdgcn_global_load_lds((const unsigned*)((const char*)(gbase) + (voff)[_i]), (LAS unsigned*)(lds + (bufoff) + ldsw + _i * 8192), 16, 0, 0); } while (0)
#define PG8_LDA(dst, b, h) do { _Pragma("unroll") for (int m = 0; m < 4; ++m) _Pragma("unroll") for (int k = 0; k < 2; ++k) dst[m][k] = *(const LAS bf16x8*)(lds + PG8_SA(b, h) + aoff + m * 2048 + k * 1024); } while (0)
#define PG8_LDB(dst, b, h) do { _Pragma("unroll") for (int n = 0; n < 2; ++n) _Pragma("unroll") for (int k = 0; k < 2; ++k) dst[n][k] = *(const LAS bf16x8*)(lds + PG8_SB(b, h) + boff + n * 2048 + k * 1024); } while (0)
#define PG8_MMA(ai, bj, At, Bt) do { __builtin_amdgcn_s_setprio(1); _Pragma("unroll") for (int m = 0; m < 4; ++m) _Pragma("unroll") for (int n = 0; n < 2; ++n) _Pragma("unroll") for (int k = 0; k < 2; ++k) \
        acc[ai][bj][m][n] = __builtin_amdgcn_mfma_f32_16x16x32_bf16(Bt[n][k], At[m][k], acc[ai][bj][m][n], 0, 0, 0); __builtin_amdgcn_s_setprio(0); } while (0)
#define PG8_WAIT_V(n) asm volatile("s_waitcnt vmcnt(" #n ")" ::: "memory")
#define PG8_WAIT_L(n) asm volatile("s_waitcnt lgkmcnt(" #n ")" ::: "memory")
#define PG8_BAR __builtin_amdgcn_s_barrier()
#define PG8_SCHED __builtin_amdgcn_sched_barrier(0)
    Unit cur, nxt; int ui = 0;
    if (!S.next(0, cur)) return;
    f32x4 acc[2][2][4][2];
#pragma unroll
    for (int a = 0; a < 2; ++a)
#pragma unroll
        for (int b = 0; b < 2; ++b)
#pragma unroll
            for (int m = 0; m < 4; ++m)
#pragma unroll
                for (int n = 0; n < 2; ++n) acc[a][b][m][n] = (f32x4){0.f, 0.f, 0.f, 0.f};
    bf16x8 At[4][2], B0[2][2], B1[2][2];
    const char* cA = (const char*)g.A + (size_t)cur.pm * tstepA; const char* cB = (const char*)g.Bt + (size_t)cur.pn * tstepB;
    PG8_STAGE(PG8_SB(0, 0), cB, voffB); PG8_STAGE(PG8_SB(0, 1), cB + hstepB, voffB); PG8_STAGE(PG8_SA(0, 0), cA, voffA); PG8_STAGE(PG8_SA(0, 1), cA + hstepA, voffA);
    if (wr == 1) PG8_BAR;
    PG8_WAIT_V(2); PG8_BAR;
    PG8_STAGE(PG8_SB(1, 0), cB + kstep, voffB); PG8_STAGE(PG8_SA(1, 0), cA + AK(1), voffA); PG8_STAGE(PG8_SB(1, 1), cB + hstepB + kstep, voffB);
    PG8_WAIT_V(6); PG8_BAR;
    for (;;) {
        const bool has_next = S.next(ui + 1, nxt);
        const char* nA = has_next ? (const char*)g.A + (size_t)nxt.pm * tstepA : cA; const char* nB = has_next ? (const char*)g.Bt + (size_t)nxt.pn * tstepB : cB;
        const int nt = cur.nt;
        for (int t = 0; t < nt; t += 2) {
            const bool last = (t == nt - 2);
            const char* a1 = cA + AK(t + 1);
            const char* a2 = last ? nA : cA + AK(t + 2); const char* b2 = last ? nB : cB + (size_t)(t + 2) * kstep;
            const char* a3 = last ? nA + AK(1) : cA + AK(t + 3); const char* b3 = b2 + kstep;
            PG8_LDB(B0, 0, 0); PG8_LDB(B1, 0, 1); PG8_SCHED; PG8_LDA(At, 0, 0); PG8_STAGE(PG8_SA(1, 1), a1 + hstepA, voffA);
            PG8_WAIT_V(8); PG8_WAIT_L(0); PG8_BAR; PG8_MMA(0, 0, At, B0); PG8_MMA(0, 1, At, B1); PG8_BAR; PG8_SCHED;
            PG8_LDA(At, 0, 1); PG8_STAGE(PG8_SB(0, 0), b2, voffB); PG8_STAGE(PG8_SB(0, 1), b2 + hstepB, voffB); PG8_STAGE(PG8_SA(0, 0), a2, voffA);
            PG8_WAIT_V(8); PG8_WAIT_L(0); PG8_BAR; PG8_MMA(1, 0, At, B0); PG8_MMA(1, 1, At, B1); PG8_BAR; PG8_SCHED;
            PG8_LDB(B0, 1, 0); PG8_LDB(B1, 1, 1); PG8_SCHED; PG8_LDA(At, 1, 0); PG8_STAGE(PG8_SA(0, 1), a2 + hstepA, voffA);
            PG8_WAIT_V(8); PG8_WAIT_L(0); PG8_BAR; PG8_MMA(0, 0, At, B0); PG8_MMA(0, 1, At, B1); PG8_BAR; PG8_SCHED;
            PG8_LDA(At, 1, 1); PG8_STAGE(PG8_SB(1, 0), b3, voffB); PG8_STAGE(PG8_SB(1, 1), b3 + hstepB, voffB); PG8_STAGE(PG8_SA(1, 0), a3, voffA);
            PG8_WAIT_V(8); PG8_WAIT_L(0); PG8_BAR; PG8_MMA(1, 0, At, B0); PG8_MMA(1, 1, At, B1); PG8_BAR; PG8_SCHED;
        }
        if constexpr (ALIGN_EPI) { if (wr == 0) PG8_BAR; }
        { int pm_ = cur.pm, pn_ = cur.pn; asm volatile("" : "+s"(pm_), "+s"(pn_)); cur.pm = pm_; cur.pn = pn_; }
        E(acc, cur, wr, wc, fr, fq);
        if (!has_next) break;
#pragma unroll
        for (int a = 0; a < 2; ++a)
#pragma unroll
            for (int b = 0; b < 2; ++b)
#pragma unroll
                for (int m = 0; m < 4; ++m)
#pragma unroll
                    for (int n = 0; n < 2; ++n) acc[a][b][m][n] = (f32x4){0.f, 0.f, 0.f, 0.f};
        cur = nxt; cA = nA; cB = nB; ++ui;
        if constexpr (ALIGN_EPI) { if (wr == 1) PG8_BAR; }
    }
    PG8_WAIT_V(0);
    if constexpr (!ALIGN_EPI) { if (wr == 0) PG8_BAR; }
    PG8_BAR;
#undef PG8_SA
#undef PG8_SB
#undef PG8_STAGE
#undef PG8_LDA
#undef PG8_LDB
#undef PG8_MMA
#undef PG8_WAIT_V
#undef PG8_WAIT_L
#undef PG8_BAR
#undef PG8_SCHED
}

#define EPI_ROW(u, ai, m) ((u).pm * BM + (ai) * HALF + wr * 64 + (m) * 16 + fr)
typedef const f32x4 (&AccRef)[2][2][4][2];
#define LN_OFF(tile, ai, m, bj) ((((size_t)(tile) * 8 + (wr * 4 + wc)) * 2 + (ai)) * 4096 + (size_t)(fq * 16 + fr) * 8 + 2048 + (((m) * 2 + (bj)) * 512 - 2048))

__device__ __forceinline__ void row_scales(const float* ssp, const Unit& u, int wr, int fr, int fq, float (&r)[2][4]) {
    f32x4 p[2][4];
#pragma unroll
    for (int ai = 0; ai < 2; ++ai)
#pragma unroll
        for (int m = 0; m < 4; ++m) p[ai][m] = *(const f32x4*)(ssp + (size_t)EPI_ROW(u, ai, m) * 16 + 4 * fq);
#pragma unroll
    for (int ai = 0; ai < 2; ++ai)
#pragma unroll
        for (int m = 0; m < 4; ++m) { float s = (p[ai][m][0] + p[ai][m][1]) + (p[ai][m][2] + p[ai][m][3]); s += __shfl_xor(s, 16); s += __shfl_xor(s, 32); r[ai][m] = rsqrtf(s * (1.0f / DM) + EPS); }
}
constexpr int LDS_RS_OFF = 131072;
__device__ __forceinline__ void row_scales_to_lds(const float* ssp, int pm0, LAS float* rlds) {
    const int tid = threadIdx.x, slot = tid >> 8, rowl = tid & 255;
    const f32x4* sp = (const f32x4*)(ssp + ((size_t)(pm0 + 8 * slot) * BM + rowl) * 16);
    const f32x4 s4 = (sp[0] + sp[1]) + (sp[2] + sp[3]);
    rlds[tid] = rsqrtf(((s4[0] + s4[1]) + (s4[2] + s4[3])) * (1.0f / DM) + EPS);
    __syncthreads();
}
__device__ __forceinline__ void row_scales1_to_lds(const float* ss, int pm0, LAS float* rlds) {
    const int tid = threadIdx.x, slot = tid >> 8, rowl = tid & 255;
    rlds[tid] = rsqrtf(ss[(size_t)(pm0 + 8 * slot) * BM + rowl] * (1.0f / DM) + EPS);
    __syncthreads();
}
__device__ __forceinline__ void row_scales_from_lds(const LAS float* rlds, const Unit& u, int wr, int fr, float (&r)[2][4]) {
    const LAS float* p = rlds + ((u.pm >> 3) & 1) * 256 + wr * 64 + fr;
#pragma unroll
    for (int ai = 0; ai < 2; ++ai)
#pragma unroll
        for (int m = 0; m < 4; ++m) r[ai][m] = p[ai * HALF + m * 16];
}
struct EpiInProj {
    static constexpr bool PERM = true;
    const float* ss0; bf16_t* aext; bf16_t* sz; const LAS float* rlds;
    __device__ __forceinline__ void operator()(AccRef acc, const Unit& u, int wr, int wc, int fr, int fq) const {
        float sr[2][4];
        if (rlds) row_scales_from_lds(rlds, u, wr, fr, sr);
        else {
#pragma unroll
            for (int ai = 0; ai < 2; ++ai)
#pragma unroll
                for (int m = 0; m < 4; ++m) sr[ai][m] = ss0[EPI_ROW(u, ai, m)];
#pragma unroll
            for (int ai = 0; ai < 2; ++ai)
#pragma unroll
                for (int m = 0; m < 4; ++m) sr[ai][m] = rsqrtf(sr[ai][m] * (1.0f / DM) + EPS);
        }
#pragma unroll
        for (int ai = 0; ai < 2; ++ai)
#pragma unroll
            for (int m = 0; m < 4; ++m) {
                const int row = EPI_ROW(u, ai, m); const float r = sr[ai][m];
#pragma unroll
                for (int bj = 0; bj < 2; ++bj) {
                    const int col8 = u.pn * BM + bj * HALF + wc * 32 + 8 * fq;
                    f32x4 v0 = acc[ai][bj][m][0] * r, v1 = acc[ai][bj][m][1] * r;
                    if (u.pn < 4) { const int g = col8 >> 4, cc = col8 & 15, chunk = row / TC, s = row % TC;
                        *(u32x4*)(aext + ((size_t)(g * NCHUNK + chunk) * KX + 128 + s * 16 + cc)) = pack8(v0, v1); }
                    else *(u32x4*)(sz + LN_OFF(u.pm * 4 + (u.pn - 4), ai, m, bj)) = pack8(silu4(v0), silu4(v1));
                }
            }
    }
};
struct EpiStore {
    static constexpr bool PERM = true;
    bf16_t* o;
    __device__ __forceinline__ void operator()(AccRef acc, const Unit& u, int wr, int wc, int fr, int fq) const {
#pragma unroll
        for (int ai = 0; ai < 2; ++ai)
#pragma unroll
            for (int m = 0; m < 4; ++m) {
#pragma unroll
                for (int bj = 0; bj < 2; ++bj) *(u32x4*)(o + LN_OFF(u.pm * 4 + u.pn, ai, m, bj)) = pack8(acc[ai][bj][m][0], acc[ai][bj][m][1]); }
    }
};
struct EpiY {
    static constexpr bool PERM = true;
    bf16_t* yb;
    __device__ __forceinline__ void operator()(AccRef acc, const Unit& u, int wr, int wc, int fr, int fq) const {
        const int g = u.pm >> 3, ir = u.pm & 7;
#pragma unroll
        for (int ai = 0; ai < 2; ++ai)
#pragma unroll
            for (int m = 0; m < 4; ++m) { const int chunk = ir * 256 + ai * HALF + wr * 64 + m * 16 + fr;
#pragma unroll
                for (int bj = 0; bj < 2; ++bj) { const int idx = bj * HALF + wc * 32 + 8 * fq, t = idx >> 4, c = idx & 15;
                    *(u32x4*)(yb + ((size_t)g * M + chunk * TC + t) * GC + c) = pack8(gelu4(acc[ai][bj][m][0]), gelu4(acc[ai][bj][m][1])); } }
    }
};
struct EpiGlu {
    static constexpr bool PERM = true;
    const bf16_t* sz; bf16_t* gb;
    __device__ __forceinline__ void operator()(AccRef acc, const Unit& u, int wr, int wc, int fr, int fq) const {
        u32x4 zq[2][4];
#pragma unroll
        for (int ai = 0; ai < 2; ++ai)
#pragma unroll
            for (int m = 0; m < 4; ++m) zq[ai][m] = __builtin_nontemporal_load((const u32x4*)(sz + LN_OFF(u.pm * 4 + (u.pn >> 1), ai, m, u.pn & 1)));
#pragma unroll
        for (int ai = 0; ai < 2; ++ai)
#pragma unroll
            for (int m = 0; m < 4; ++m) { const size_t off = LN_OFF(u.pm * 4 + (u.pn >> 1), ai, m, u.pn & 1);
                f32x4 z0, z1; unpack8(zq[ai][m], z0, z1);
                const f32x4 o0 = acc[ai][0][m][0] * sig4(acc[ai][1][m][0]) * z0, o1 = acc[ai][0][m][1] * sig4(acc[ai][1][m][1]) * z1;
                *(u32x4*)(gb + off) = pack8(o0, o1); }
    }
};
template <bool BASE_BF16, bool BASE_LN = true> struct EpiOutRes {
    static constexpr bool PERM = true;
    static constexpr int NG = BASE_BF16 ? 8 : 4;
    const float* basef; const bf16_t* baseb; bf16_t* xb; float* ssp;
    __device__ __forceinline__ void operator()(AccRef acc, const Unit& u, int wr, int wc, int fr, int fq) const {
#pragma unroll
        for (int g0 = 0; g0 < 8; g0 += NG) {
            f32x4 bf_[BASE_BF16 ? 1 : NG][2][2]; u32x4 bb_[BASE_BF16 ? NG : 1][2];
#pragma unroll
            for (int gg = 0; gg < NG; ++gg)
#pragma unroll
                for (int bj = 0; bj < 2; ++bj) { const int ai = (g0 + gg) >> 2, m = (g0 + gg) & 3; const size_t off = BASE_LN ? LN_OFF(u.pm * 4 + u.pn, ai, m, bj) : (size_t)EPI_ROW(u, ai, m) * DM + u.pn * BM + bj * HALF + wc * 32 + 8 * fq;
                    if constexpr (BASE_BF16) bb_[gg][bj] = __builtin_nontemporal_load((const u32x4*)(baseb + off)); else { bf_[gg][bj][0] = *(const f32x4*)(basef + off); bf_[gg][bj][1] = *(const f32x4*)(basef + off + 4); } }
#pragma unroll
            for (int gg = 0; gg < NG; ++gg) { const int ai = (g0 + gg) >> 2, m = (g0 + gg) & 3; const int row = EPI_ROW(u, ai, m); float q = 0.f;
#pragma unroll
                for (int bj = 0; bj < 2; ++bj) { const size_t off = LN_OFF(u.pm * 4 + u.pn, ai, m, bj);
                    f32x4 b0, b1;
                    if constexpr (BASE_BF16) unpack8(bb_[gg][bj], b0, b1); else { b0 = bf_[gg][bj][0]; b1 = bf_[gg][bj][1]; }
                    const f32x4 v0 = acc[ai][bj][m][0] + b0, v1 = acc[ai][bj][m][1] + b1;
                    *(u32x4*)(xb + off) = pack8(v0, v1); q += sumsq4(v0) + sumsq4(v1); }
                q = sum_fq(q);
                if (fq == 0) ssp[(size_t)row * 16 + u.pn * 4 + wc] = q; }
        }
    }
};
template <bool FINAL> struct EpiGate {
    static constexpr bool PERM = true;
    static constexpr int NB = 2;
    const bf16_t* xin; const bf16_t* pp; const float* ssp_in; bf16_t* xb; float* ssp_out; float* outf; const LAS float* rlds;
    __device__ __forceinline__ void operator()(AccRef acc, const Unit& u, int wr, int wc, int fr, int fq) const {
        float rs[2][4]; if (rlds) row_scales_from_lds(rlds, u, wr, fr, rs); else row_scales(ssp_in, u, wr, fr, fq, rs);
#pragma unroll
        for (int ai = 0; ai < 2; ++ai)
#pragma unroll
            for (int m0 = 0; m0 < 4; m0 += NB) {
                const bf16_t* ppa = pp + LN_OFF(u.pm * 4 + u.pn, ai, 0, 0) + 2048; asm volatile("" : "+v"(ppa));
                const bf16_t* xa = xin + LN_OFF(u.pm * 4 + u.pn, ai, 0, 0) + 2048; asm volatile("" : "+v"(xa));
                u32x4 pq[NB][2], xq[NB][2];
#pragma unroll
                for (int mm = 0; mm < NB; ++mm)
#pragma unroll
                    for (int bj = 0; bj < 2; ++bj) { pq[mm][bj] = __builtin_nontemporal_load((const u32x4*)(ppa + (((m0 + mm) * 2 + bj) * 512 - 2048))); xq[mm][bj] = *(const u32x4*)(xa + (((m0 + mm) * 2 + bj) * 512 - 2048)); }
#pragma unroll
                for (int mm = 0; mm < NB; ++mm) { const int m = m0 + mm; const int row = EPI_ROW(u, ai, m); const float r = rs[ai][m]; float q = 0.f;
#pragma unroll
                    for (int bj = 0; bj < 2; ++bj) { const size_t off = FINAL ? (size_t)row * DM + u.pn * BM + bj * HALF + wc * 32 + 8 * fq : LN_OFF(u.pm * 4 + u.pn, ai, m, bj);
                        f32x4 p0, p1, x0, x1; unpack8(pq[mm][bj], p0, p1); unpack8(xq[mm][bj], x0, x1);
                        const f32x4 v0 = x0 + sig4(acc[ai][bj][m][0] * r) * p0, v1 = x1 + sig4(acc[ai][bj][m][1] * r) * p1;
                        if (FINAL) { *(f32x4*)(outf + off) = v0; *(f32x4*)(outf + off + 4) = v1; }
                        else { *(u32x4*)(xb + off) = pack8(v0, v1); q += sumsq4(v0) + sumsq4(v1); } }
                    if (!FINAL) { q = sum_fq(q); if (fq == 0) ssp_out[(size_t)row * 16 + u.pn * 4 + wc] = q; } }
            }
    }
};
struct EpiQKV {
    static constexpr bool PERM = true;
    const float* ssp_in; const float* gk; const float* gq; bf16_t* kb; bf16_t* vb; bf16_t* qb; bf16_t* szb; float qscale; const LAS float* rlds;
    __device__ __forceinline__ void operator()(AccRef acc, const Unit& u, int wr, int wc, int fr, int fq) const {
        const int type = u.pn >> 2, colb = 256 * (u.pn & 3) + 64 * wc + 8 * fq;
        bf16_t* const dst = type == 0 ? kb : (type == 1 ? vb : (type == 2 ? qb : szb));
        const float* const gn = type == 0 ? gk : gq;
        f32x4 gv[2][2];
#pragma unroll
        for (int bj = 0; bj < 2; ++bj) { gv[bj][0] = *(const f32x4*)(gn + 32 * bj + 8 * fq); gv[bj][1] = *(const f32x4*)(gn + 32 * bj + 8 * fq + 4); }
        float rs[2][4]; if (rlds) row_scales_from_lds(rlds, u, wr, fr, rs); else row_scales(ssp_in, u, wr, fr, fq, rs);
#pragma unroll
        for (int ai = 0; ai < 2; ++ai)
#pragma unroll
            for (int m = 0; m < 4; ++m) { const int row = EPI_ROW(u, ai, m);
                const float r = rs[ai][m];
                f32x4 t[2][2];
                if (type == 0 || type == 2) {
                    float q = (sumsq4(acc[ai][0][m][0]) + sumsq4(acc[ai][0][m][1])) + (sumsq4(acc[ai][1][m][0]) + sumsq4(acc[ai][1][m][1]));
                    q = sum_fq(q);
                    const float sc = r * rsqrtf(r * r * q * (1.0f / 64.0f) + EPS) * (type == 2 ? qscale : 1.0f);
#pragma unroll
                    for (int bj = 0; bj < 2; ++bj) { t[bj][0] = acc[ai][bj][m][0] * sc * gv[bj][0]; t[bj][1] = acc[ai][bj][m][1] * sc * gv[bj][1]; }
                } else {
#pragma unroll
                    for (int bj = 0; bj < 2; ++bj) { t[bj][0] = acc[ai][bj][m][0] * r; t[bj][1] = acc[ai][bj][m][1] * r; }
                    if (type == 3) {
#pragma unroll
                        for (int bj = 0; bj < 2; ++bj) { t[bj][0] = silu4(t[bj][0]); t[bj][1] = silu4(t[bj][1]); }
                    }
                }
                if (type >= 2) {
#pragma unroll
                    for (int bj = 0; bj < 2; ++bj) *(u32x4*)(dst + (size_t)row * DM + colb + 32 * bj) = pack8(t[bj][0], t[bj][1]);
                } else {
                    const int bb = row >> 12, s = row & (SEQ - 1);
#pragma unroll
                    for (int bj = 0; bj < 2; ++bj) { const int c = colb + 32 * bj, hh = c >> 7, d = c & 127;
                        const size_t tb = ((size_t)((bb * NH + hh) * 64 + (s >> 6))) * 8192;
                        const size_t off = type == 0 ? tb + (d >> 3) * 512 + (s & 63) * 8 : tb + (d >> 5) * 2048 + (s & 63) * 32 + (d & 31);
                        *(u32x4*)(dst + off) = pack8(t[bj][0], t[bj][1]); }
                }
            }
    }
};
}

namespace att {
constexpr int SLOT = 32768, KOFF = 0, VOFF = 16384, NSLOT = 3;
constexpr int LDS_RING = 0, LDS_BT = NSLOT * SLOT, LDS_WSF = LDS_BT + 1024, LDS_MISC = LDS_WSF + 8 * 64 * 4, LDS_TOTAL = LDS_MISC + 64;
constexpr int LDS_EX = 0;
__device__ __forceinline__ int crow(int r, int hi) { return (r & 3) + 8 * (r >> 2) + 4 * hi; }
__device__ __forceinline__ void glds16(const void* gsrc, unsigned lds_dst) { unsigned keep;
    asm volatile("s_mov_b32 %0, m0\n\ts_mov_b32 m0, %2\n\ts_nop 0\n\tglobal_load_lds_dwordx4 %1, off\n\ts_mov_b32 m0, %0" : "=&s"(keep) : "v"(gsrc), "s"(lds_dst) : "memory"); }
__device__ __forceinline__ int t5_bucket(int n) {
    if (n < 16) return n;
    return 16 + (n >= 19) + (n >= 21) + (n >= 24) + (n >= 27) + (n >= 31) + (n >= 35) + (n >= 40) + (n >= 46) + (n >= 52) + (n >= 59) + (n >= 67) + (n >= 77) + (n >= 87) + (n >= 99) + (n >= 113);
}
struct Params { const bf16_t* q; const bf16_t* k; const bf16_t* v; const bf16_t* sz; bf16_t* og; const float* rel_bias; const float* gq; const float* gk;
                const float* lq1; const float* lk1; const float* lq2; const float* lk2; const float* subln; };

__device__ __forceinline__ void attn_unit(const Params& P, int bh, int qb, LAS unsigned char* shm, float lam, float qkmax) {
    const int tid = threadIdx.x, lane = tid & 63, r32 = lane & 31, hi = lane >> 5; const int wid = __builtin_amdgcn_readfirstlane(tid >> 6);
    const int cmap = wid >> 2, wq = wid & 3;
    const int b = bh >> 3, h = bh & 7; const long rowbase = (long)b * SEQ; const int q0 = qb * 128;
    const unsigned lds0 = (unsigned)(uintptr_t)shm;
    LAS float* bt = (LAS float*)(shm + LDS_BT);
    LAS float* wsf = (LAS float*)(shm + LDS_WSF) + wid * 64;
    {
        float bmax = -1e30f;
        for (int i = 0; i < 32; ++i) bmax = fmaxf(bmax, P.rel_bias[i * NH + h]);
        const float Bh = qkmax + bmax;
        if (tid <= 128) { const int n = tid - 1; bt[tid] = (tid == 0) ? -INFINITY : (P.rel_bias[t5_bucket(n) * NH + h] - Bh) * LOG2E; }
    }
    const bf16_t* Kh = P.k + rowbase * DM + h * 128; const bf16_t* Vh = P.v + rowbase * DM + h * 128;
    const bf16_t* ksrc0 = Kh + (long)lane * DM + (2 * wid) * 8; const bf16_t* ksrc1 = ksrc0 + 8;
    const int pc0 = 2 * wid, pc1 = 2 * wid + 1;
    const bf16_t* vsrc0 = Vh + (long)(16 * (pc0 & 3) + (lane >> 2)) * DM + (pc0 >> 2) * 32 + (lane & 3) * 8;
    const bf16_t* vsrc1 = Vh + (long)(16 * (pc1 & 3) + (lane >> 2)) * DM + (pc1 >> 2) * 32 + (lane & 3) * 8;
    const unsigned kdst = lds0 + LDS_RING + KOFF + (2 * wid) * 1024, vdst = lds0 + LDS_RING + VOFF + (2 * wid) * 1024;
#define DMA_TILE(t, slot) do { const long _o = (long)(t) * 64 * DM; const unsigned _s = (unsigned)(slot) * SLOT; \
    glds16(ksrc0 + _o, (unsigned)__builtin_amdgcn_readfirstlane(kdst + _s)); glds16(ksrc1 + _o, (unsigned)__builtin_amdgcn_readfirstlane(kdst + _s + 1024)); \
    glds16(vsrc0 + _o, (unsigned)__builtin_amdgcn_readfirstlane(vdst + _s)); glds16(vsrc1 + _o, (unsigned)__builtin_amdgcn_readfirstlane(vdst + _s + 1024)); } while (0)
    const int NT = 2 * qb + 2;
    DMA_TILE(0, 0); DMA_TILE(1, 1);
    const bf16_t* Qw = P.q + (rowbase + q0 + wq * 32 + r32) * DM + h * 128 + cmap * 64 + hi * 8;
    bf16x8 qr[4];
#pragma unroll
    for (int d0 = 0; d0 < 4; ++d0) qr[d0] = *(const bf16x8*)(Qw + d0 * 16);
    f32x16 o[4];
#pragma unroll
    for (int e = 0; e < 4; ++e) o[e] = f32x16{};
    float l_reg = 0.f;
    const int qpos = q0 + wq * 32 + r32;
    const int tband = (q0 - 112) >> 6;
    asm volatile("s_waitcnt vmcnt(0)" ::: "memory");
    __syncthreads();
    const float cfar = bt[128];
    int slot = 0;
    for (int t = 0; t < NT; ++t) {
        if (t > 0) { if (t + 1 < NT) asm volatile("s_waitcnt vmcnt(4)" ::: "memory"); else asm volatile("s_waitcnt vmcnt(0)" ::: "memory");
                     asm volatile("s_waitcnt lgkmcnt(0)\n\ts_barrier" ::: "memory"); }
        if (t + 2 < NT) { int s2 = slot + 2; if (s2 >= NSLOT) s2 -= NSLOT; DMA_TILE(t + 2, s2); }
        LAS unsigned char* Ks = shm + LDS_RING + slot * SLOT + KOFF;
        const int vbase = (int)(lds0 + LDS_RING + slot * SLOT + VOFF) + ((lane >> 4) & 1) * 32 + (lane & 3) * 8 + (4 * hi + ((lane & 15) >> 2)) * 64;
        const bool band = (t >= tband);
        f32x16 p0, p1;
        { const float ci = band ? 0.f : cfar;
#pragma unroll
          for (int r = 0; r < 16; ++r) { p0[r] = ci; p1[r] = ci; } }
        LAS unsigned char* kb = Ks + (cmap * 8 + hi) * 1024 + r32 * 16;
#pragma unroll
        for (int d0 = 0; d0 < 4; ++d0) {
            const bf16x8 k0 = *(const LAS bf16x8*)(kb + d0 * 2048), k1 = *(const LAS bf16x8*)(kb + d0 * 2048 + 512);
            p0 = __builtin_amdgcn_mfma_f32_32x32x16_bf16(k0, qr[d0], p0, 0, 0, 0);
            p1 = __builtin_amdgcn_mfma_f32_32x32x16_bf16(k1, qr[d0], p1, 0, 0, 0);
        }
        if (band) {
            const int nb = qpos - 64 * t - 4 * hi;
#pragma unroll
            for (int r = 0; r < 16; ++r) { const int n0 = nb - ((r & 3) + 8 * (r >> 2)); int i0 = n0 + 1, i1 = n0 - 31;
                i0 = i0 < 0 ? 0 : (i0 > 128 ? 128 : i0); i1 = i1 < 0 ? 0 : (i1 > 128 ? 128 : i1);
                p0[r] += bt[i0]; p1[r] += bt[i1]; }
        }
        float sacc = 0.f;
#pragma unroll
        for (int r = 0; r < 16; ++r) { p0[r] = __builtin_amdgcn_exp2f(p0[r]); p1[r] = __builtin_amdgcn_exp2f(p1[r]); sacc += p0[r] + p1[r]; }
        l_reg += sacc;
        u32x4 pw[4];
        pw[0] = (u32x4){cvtpk(p0[0], p0[1]), cvtpk(p0[2], p0[3]), cvtpk(p0[4], p0[5]), cvtpk(p0[6], p0[7])};
        pw[1] = (u32x4){cvtpk(p0[8], p0[9]), cvtpk(p0[10], p0[11]), cvtpk(p0[12], p0[13]), cvtpk(p0[14], p0[15])};
        pw[2] = (u32x4){cvtpk(p1[0], p1[1]), cvtpk(p1[2], p1[3]), cvtpk(p1[4], p1[5]), cvtpk(p1[6], p1[7])};
        pw[3] = (u32x4){cvtpk(p1[8], p1[9]), cvtpk(p1[10], p1[11]), cvtpk(p1[12], p1[13]), cvtpk(p1[14], p1[15])};
#pragma unroll
        for (int eb = 0; eb < 4; ++eb) {
            s16x4 lo[4], hi4[4];
#pragma unroll
            for (int ks = 0; ks < 4; ++ks) {
                asm volatile("ds_read_b64_tr_b16 %0,%1 offset:%c2" : "=&v"(lo[ks]) : "v"(vbase), "i"(eb * 4096 + ks * 1024) : "memory");
                asm volatile("ds_read_b64_tr_b16 %0,%1 offset:%c2" : "=&v"(hi4[ks]) : "v"(vbase), "i"(eb * 4096 + ks * 1024 + 512) : "memory");
            }
            asm volatile("s_waitcnt lgkmcnt(0)" ::: "memory"); __builtin_amdgcn_sched_barrier(0);
#pragma unroll
            for (int ks = 0; ks < 4; ++ks) {
                const bf16x8 vf = (bf16x8){lo[ks][0], lo[ks][1], lo[ks][2], lo[ks][3], hi4[ks][0], hi4[ks][1], hi4[ks][2], hi4[ks][3]};
                o[eb] = __builtin_amdgcn_mfma_f32_32x32x16_bf16(__builtin_bit_cast(bf16x8, pw[ks]), vf, o[eb], 0, 0, 0);
            }
        }
        slot = (slot + 1 == NSLOT) ? 0 : slot + 1;
    }
#undef DMA_TILE
    { auto rr = __builtin_amdgcn_permlane32_swap(__float_as_uint(l_reg), __float_as_uint(l_reg), false, false); l_reg = __uint_as_float(rr[0]) + __uint_as_float(rr[1]); }
    if (hi == 0) wsf[r32] = l_reg;
    asm volatile("s_waitcnt lgkmcnt(0)" ::: "memory");
    float rl[16];
#pragma unroll
    for (int r = 0; r < 16; ++r) rl[r] = __builtin_amdgcn_rcpf(wsf[crow(r, hi)]) * (cmap ? lam : 1.0f);
    asm volatile("s_waitcnt lgkmcnt(0)\n\ts_barrier" ::: "memory");
    LAS float* ex = (LAS float*)(shm + LDS_EX) + wq * 4096;
    if (cmap == 1) {
#pragma unroll
        for (int eb = 0; eb < 4; ++eb)
#pragma unroll
            for (int r = 0; r < 16; ++r) ex[(eb * 16 + r) * 64 + lane] = o[eb][r] * rl[r];
    }
    __syncthreads();
    if (cmap == 0) {
        float ssq[16];
#pragma unroll
        for (int r = 0; r < 16; ++r) ssq[r] = 0.f;
#pragma unroll
        for (int eb = 0; eb < 4; ++eb)
#pragma unroll
            for (int r = 0; r < 16; ++r) { const float v = o[eb][r] * rl[r] - ex[(eb * 16 + r) * 64 + lane]; o[eb][r] = v; ssq[r] += v * v; }
#pragma unroll
        for (int r = 0; r < 16; ++r) { float s = ssq[r]; s += __shfl_xor(s, 1); s += __shfl_xor(s, 2); s += __shfl_xor(s, 4); s += __shfl_xor(s, 8); s += __shfl_xor(s, 16);
            ssq[r] = rsqrtf(s * (1.0f / 128.0f) + EPS) * (1.0f - LAM_INIT); }
#pragma unroll
        for (int eb = 0; eb < 4; ++eb) { const float gsub = P.subln[eb * 32 + r32];
#pragma unroll
            for (int r = 0; r < 16; ++r) { const size_t off = (size_t)(rowbase + q0 + wq * 32 + crow(r, hi)) * DM + h * 128 + eb * 32 + r32;
                P.og[off] = f2bf(o[eb][r] * ssq[r] * gsub * bf2f(P.sz[off])); } }
    }
    __syncthreads();
}

__device__ __forceinline__ void attn_phase(const Params& P, LAS unsigned char* shm, int vcu, int G) {
    LAS float* misc = (LAS float*)(shm + LDS_MISC);
    if (threadIdx.x < 64) {
        const int l = threadIdx.x;
        float s1 = wave_sum(P.lq1[l] * P.lk1[l]), s2 = wave_sum(P.lq2[l] * P.lk2[l]);
        float mq = fabsf(P.gq[l]), mk = fabsf(P.gk[l]);
#pragma unroll
        for (int o = 1; o < 64; o <<= 1) { mq = fmaxf(mq, __shfl_xor(mq, o)); mk = fmaxf(mk, __shfl_xor(mk, o)); }
        if (l == 0) { misc[0] = expf(s1) - expf(s2) + LAM_INIT; misc[1] = 8.0f * mq * mk; }
    }
    __syncthreads();
    const float lam = misc[0], qkmax = misc[1];
    for (int U = vcu; U < 2048; U += G) {
        const int vv = U & 255, i = U >> 8, bh = vv >> 2, j = vv & 3;
        const int qb = (i & 1) ? (8 * (i >> 1) + 7 - j) : (8 * (i >> 1) + j);
        attn_unit(P, bh, qb, shm, lam, qkmax);
    }
}
}

namespace att2 {
using att::crow; using att::glds16; using att::t5_bucket; using att::Params;
constexpr int SLOTB = 16384, NSLOT = 3;
constexpr int LDS_K = 0, LDS_V = NSLOT * SLOTB, LDS_EX = 65536, LDS_BT = 131072, BT_STRIDE = 132, LDS_WSF = LDS_BT + 8 * BT_STRIDE * 4 + 128, LDS_MISC = LDS_WSF + 8 * 64 * 4, LDS_EXT = LDS_MISC + 128, LDS_TOTAL = LDS_EXT + 384 * 4;
typedef LAS const unsigned char* lds_cptr;
typedef short v4i16_t __attribute__((ext_vector_type(4)));
#define SBAR() __builtin_amdgcn_sched_barrier(0)
#define WAIT_BAR(N) asm volatile("s_waitcnt vmcnt(" #N ") lgkmcnt(0)\n\ts_barrier" ::: "memory")
__device__ __forceinline__ float rowsum32(float s) {
    s += __builtin_bit_cast(float, __builtin_amdgcn_update_dpp(0, __builtin_bit_cast(int, s), 0xB1, 0xF, 0xF, true));
    s += __builtin_bit_cast(float, __builtin_amdgcn_update_dpp(0, __builtin_bit_cast(int, s), 0x4E, 0xF, 0xF, true));
    s += __builtin_bit_cast(float, __builtin_amdgcn_update_dpp(0, __builtin_bit_cast(int, s), 0x141, 0xF, 0xF, true));
    s += __builtin_bit_cast(float, __builtin_amdgcn_update_dpp(0, __builtin_bit_cast(int, s), 0x140, 0xF, 0xF, true));
    auto rr = __builtin_amdgcn_permlane16_swap(__float_as_uint(s), __float_as_uint(s), false, false);
    return __uint_as_float(rr[0]) + __uint_as_float(rr[1]);
}
__device__ __forceinline__ s16x4 vtr(lds_cptr p) { return __builtin_bit_cast(s16x4, __builtin_amdgcn_ds_read_tr16_b64_v4i16((LAS v4i16_t*)p)); }
__device__ __forceinline__ void kload2(bf16x8* kf, lds_cptr kp, int j) { kf[2 * j] = *(const LAS bf16x8*)(kp + j * 2048); kf[2 * j + 1] = *(const LAS bf16x8*)(kp + j * 2048 + 512); }

__device__ __forceinline__ void attn_unit(const Params& P, int bh, int qb, LAS unsigned char* shm, float lam, bool first, bool has_next, int nbh, int nqb, bf16x8 (&qr)[4]) {
    const int tid = threadIdx.x, lane = tid & 63, r32 = lane & 31, hi = lane >> 5; const int wid = __builtin_amdgcn_readfirstlane(tid >> 6);
    const int cmap = wid >> 2, wq = wid & 3;
    const int b = bh >> 3, h = bh & 7; const long rowbase = (long)b * SEQ; const int q0 = qb * 128;
    const unsigned lds0 = (unsigned)(uintptr_t)shm;
    LAS float* bt = (LAS float*)(shm + LDS_BT) + h * BT_STRIDE;
    LAS float* wsf = (LAS float*)(shm + LDS_WSF) + wid * 64;
    const bf16_t* ksrc0 = P.k + (size_t)bh * 64 * 8192 + (2 * wid) * 512 + lane * 8; const bf16_t* ksrc1 = ksrc0 + 512;
    const bf16_t* vsrc0 = P.v + (size_t)bh * 64 * 8192 + (2 * wid) * 512 + lane * 8; const bf16_t* vsrc1 = vsrc0 + 512;
    const unsigned kdst = lds0 + LDS_K + (2 * wid) * 1024, vdst = lds0 + LDS_V + (2 * wid) * 1024;
    const int NT = 2 * qb + 2;
#define TCL(t) ((t) < NT ? (t) : NT - 1)
#define DMA_K0(t, slot) glds16(ksrc0 + (long)TCL(t) * 8192, (unsigned)__builtin_amdgcn_readfirstlane(kdst + (slot)))
#define DMA_K1(t, slot) glds16(ksrc1 + (long)TCL(t) * 8192, (unsigned)__builtin_amdgcn_readfirstlane(kdst + (slot) + 1024))
#define DMA_V0(t, slot) glds16(vsrc0 + (long)TCL(t) * 8192, (unsigned)__builtin_amdgcn_readfirstlane(vdst + (slot)))
#define DMA_V1(t, slot) glds16(vsrc1 + (long)TCL(t) * 8192, (unsigned)__builtin_amdgcn_readfirstlane(vdst + (slot) + 1024))
#define DMA_K(t, slot) do { DMA_K0(t, slot); DMA_K1(t, slot); } while (0)
#define DMA_V(t, slot) do { DMA_V0(t, slot); DMA_V1(t, slot); } while (0)
    if (first) { DMA_K(0, 0); DMA_V(0, 0); DMA_K(1, SLOTB); DMA_K(2, 2 * SLOTB); }
    if (first) { const bf16_t* Qw = P.q + (rowbase + q0 + wq * 32 + r32) * DM + h * 128 + cmap * 64 + hi * 8;
#pragma unroll
        for (int d0 = 0; d0 < 4; ++d0) qr[d0] = *(const bf16x8*)(Qw + d0 * 16); }
    f32x16 o[4];
#pragma unroll
    for (int e = 0; e < 4; ++e) o[e] = f32x16{};
    float l_reg = 0.f;
    const int qpos = q0 + wq * 32 + r32;
    const int tband = (q0 - 112) >> 6;
    const lds_cptr shm3 = (lds_cptr)shm;
    const lds_cptr kp0 = shm3 + LDS_K + (cmap * 8 + hi) * 1024 + r32 * 16;
    const lds_cptr vp0 = shm3 + LDS_V + ((lane >> 4) & 1) * 32 + (lane & 3) * 8 + (4 * hi + ((lane & 15) >> 2)) * 64;
    bf16x8 kf[8];
    LAS float* ext = (LAS float*)(shm + LDS_EXT);
    if (tid < 384) { int i_ = tid - 126; i_ = i_ < 0 ? 0 : (i_ > 128 ? 128 : i_); ext[tid] = bt[i_]; }
    asm volatile("s_waitcnt vmcnt(0) lgkmcnt(0)\n\ts_barrier" ::: "memory");
#define BAND(C0, C1, t) do { if ((t) >= tband) { const int nb_ = qpos - 64 * (t) - 4 * hi; \
        _Pragma("unroll") for (int r = 0; r < 16; ++r) { const int c_ = (r & 3) + 8 * (r >> 2); int j0_ = nb_ + 127 - c_, j1_ = nb_ + 95 - c_; \
            asm volatile("" : "+v"(j0_), "+v"(j1_)); C0[r] += ext[j0_]; C1[r] += ext[j1_]; } } } while (0)
    f32x16 pA0, pA1, pB0, pB1;
    { kload2(kf, kp0, 0); kload2(kf, kp0, 1); kload2(kf, kp0, 2); kload2(kf, kp0, 3);
      pA0 = f32x16{}; pA1 = f32x16{};
#pragma unroll
      for (int d0 = 0; d0 < 4; ++d0) { pA0 = __builtin_amdgcn_mfma_f32_32x32x16_bf16(kf[2 * d0], qr[d0], pA0, 0, 0, 0); pA1 = __builtin_amdgcn_mfma_f32_32x32x16_bf16(kf[2 * d0 + 1], qr[d0], pA1, 0, 0, 0); }
      BAND(pA0, pA1, 0);
#pragma unroll
      for (int r = 0; r < 16; ++r) { pA0[r] = __builtin_amdgcn_exp2f(pA0[r]); pA1[r] = __builtin_amdgcn_exp2f(pA1[r]); } }
    WAIT_BAR(0);
    DMA_K(3, 0); DMA_V(1, SLOTB);
    int sl_prev = 0, sl_cur = SLOTB, sl_next = 2 * SLOTB;
#define ROT() do { sl_prev = sl_cur; sl_cur = sl_next; sl_next = (sl_next == (NSLOT - 1) * SLOTB) ? 0 : sl_next + SLOTB; } while (0)
    kload2(kf, kp0 + sl_cur, 0); kload2(kf, kp0 + sl_cur, 1); kload2(kf, kp0 + sl_cur, 2); kload2(kf, kp0 + sl_cur, 3);
    WAIT_BAR(4);
    s16x4 vlo[8], vhi[8]; u32x4 pw0, pw1, pw2, pw3;
#define PKW(Pv, B) cvtpk(Pv[B], Pv[B + 1])
#define PAF(k) __builtin_bit_cast(bf16x8, pw##k)
#define VFR(i) (bf16x8){vlo[i][0], vlo[i][1], vlo[i][2], vlo[i][3], vhi[i][0], vhi[i][1], vhi[i][2], vhi[i][3]}
#define PIN(x) asm volatile("" : "+v"(x))
#define VRD(f) do { vlo[(f) & 7] = vtr(vp_ + (((f) & 3) * 4096 + ((f) >> 2) * 1024)); vhi[(f) & 7] = vtr(vp_ + (((f) & 3) * 4096 + ((f) >> 2) * 1024 + 512)); } while (0)
#define GAPA(MF, A0, A1, A2, A3, W0, W1, PW) do { MF; sacc += A0; sacc += A1; sacc += A2; sacc += A3; PIN(sacc); W0; W1; PIN(PW); SBAR(); } while (0)
#define EX(v) __builtin_amdgcn_exp2f(v)
#define GAPB(MF, X, B) do { MF; X[B] = EX(X[B]); X[B + 1] = EX(X[B + 1]); PIN(X); SBAR(); } while (0)
#define PVM(i, k) o[(i) & 3] = __builtin_amdgcn_mfma_f32_32x32x16_bf16(PAF(k), VFR((i) & 7), o[(i) & 3], 0, 0, 0)
#define STEP(C0, C1, P0, P1, t) do { SBAR(); \
    const lds_cptr vp_ = vp0 + sl_prev; const f32x16 zz_ = f32x16{}; \
    VRD(0); SBAR(); float sacc = (P0[0] + P0[1]); \
    GAPA(C0 = __builtin_amdgcn_mfma_f32_32x32x16_bf16(kf[0], qr[0], zz_, 0, 0, 0), P0[2], P0[3], P0[4], P0[5],     pw0[0] = PKW(P0, 0), pw0[1] = PKW(P0, 2), pw0); \
    VRD(1); SBAR(); GAPA(C1 = __builtin_amdgcn_mfma_f32_32x32x16_bf16(kf[1], qr[0], zz_, 0, 0, 0), P0[6], P0[7], P0[8], P0[9],     pw0[2] = PKW(P0, 4), pw0[3] = PKW(P0, 6), pw0); \
    VRD(2); SBAR(); GAPA(C0 = __builtin_amdgcn_mfma_f32_32x32x16_bf16(kf[2], qr[1], C0, 0, 0, 0),   P0[10], P0[11], P0[12], P0[13], pw1[0] = PKW(P0, 8), pw1[1] = PKW(P0, 10), pw1); \
    VRD(3); SBAR(); GAPA(C1 = __builtin_amdgcn_mfma_f32_32x32x16_bf16(kf[3], qr[1], C1, 0, 0, 0),   P0[14], P0[15], P1[0], P1[1],   pw1[2] = PKW(P0, 12), pw1[3] = PKW(P0, 14), pw1); \
    VRD(4); SBAR(); GAPA(C0 = __builtin_amdgcn_mfma_f32_32x32x16_bf16(kf[4], qr[2], C0, 0, 0, 0),   P1[2], P1[3], P1[4], P1[5],     pw2[0] = PKW(P1, 0), pw2[1] = PKW(P1, 2), pw2); \
    VRD(5); SBAR(); GAPA(C1 = __builtin_amdgcn_mfma_f32_32x32x16_bf16(kf[5], qr[2], C1, 0, 0, 0),   P1[6], P1[7], P1[8], P1[9],     pw2[2] = PKW(P1, 4), pw2[3] = PKW(P1, 6), pw2); \
    VRD(6); SBAR(); GAPA(C0 = __builtin_amdgcn_mfma_f32_32x32x16_bf16(kf[6], qr[3], C0, 0, 0, 0),   P1[10], P1[11], P1[12], P1[13], pw3[0] = PKW(P1, 8), pw3[1] = PKW(P1, 10), pw3); \
    VRD(7); SBAR(); GAPA(C1 = __builtin_amdgcn_mfma_f32_32x32x16_bf16(kf[7], qr[3], C1, 0, 0, 0),   P1[14], P1[15], 0.f, 0.f,       pw3[2] = PKW(P1, 12), pw3[3] = PKW(P1, 14), pw3); \
    l_reg += sacc; \
    BAND(C0, C1, t); \
    SBAR(); \
    GAPB(PVM(0, 0), C0, 0);   VRD(8);  SBAR(); \
    GAPB(PVM(1, 0), C0, 2);   VRD(9);  SBAR(); \
    GAPB(PVM(2, 0), C0, 4);   VRD(10); SBAR(); \
    GAPB(PVM(3, 0), C0, 6);   VRD(11); SBAR(); \
    GAPB(PVM(4, 1), C0, 8);   VRD(12); SBAR(); \
    GAPB(PVM(5, 1), C0, 10);  VRD(13); SBAR(); \
    GAPB(PVM(6, 1), C0, 12);  VRD(14); SBAR(); \
    GAPB(PVM(7, 1), C0, 14);  VRD(15); SBAR(); \
    GAPB(PVM(8, 2), C1, 0);   kload2(kf, kp0 + sl_next, 0); SBAR(); \
    GAPB(PVM(9, 2), C1, 2);   kload2(kf, kp0 + sl_next, 1); SBAR(); \
    GAPB(PVM(10, 2), C1, 4);  kload2(kf, kp0 + sl_next, 2); SBAR(); \
    GAPB(PVM(11, 2), C1, 6);  kload2(kf, kp0 + sl_next, 3); SBAR(); \
    GAPB(PVM(12, 3), C1, 8);  DMA_V0((t) + 1, sl_next); SBAR(); \
    GAPB(PVM(13, 3), C1, 10); DMA_V1((t) + 1, sl_next); SBAR(); \
    GAPB(PVM(14, 3), C1, 12); DMA_K0((t) + 3, sl_cur); SBAR(); \
    GAPB(PVM(15, 3), C1, 14); DMA_K1((t) + 3, sl_cur); SBAR(); \
    } while (0)
    int t = 1;
    for (; t + 1 < NT; t += 2) {
        STEP(pB0, pB1, pA0, pA1, t);     WAIT_BAR(4); ROT();
        STEP(pA0, pA1, pB0, pB1, t + 1); WAIT_BAR(4); ROT();
    }
    STEP(pB0, pB1, pA0, pA1, NT - 1); WAIT_BAR(4); ROT();
    { float sacc = pB0[0] + pB0[1];
#pragma unroll
      for (int r = 2; r < 16; ++r) sacc += pB0[r];
#pragma unroll
      for (int r = 0; r < 16; ++r) sacc += pB1[r];
      l_reg += sacc;
      pw0 = (u32x4){PKW(pB0, 0), PKW(pB0, 2), PKW(pB0, 4), PKW(pB0, 6)}; pw1 = (u32x4){PKW(pB0, 8), PKW(pB0, 10), PKW(pB0, 12), PKW(pB0, 14)};
      pw2 = (u32x4){PKW(pB1, 0), PKW(pB1, 2), PKW(pB1, 4), PKW(pB1, 6)}; pw3 = (u32x4){PKW(pB1, 8), PKW(pB1, 10), PKW(pB1, 12), PKW(pB1, 14)};
      const lds_cptr vp_ = vp0 + sl_prev;
      VRD(0); VRD(1); VRD(2); VRD(3); VRD(4); VRD(5); VRD(6); VRD(7);
      PVM(0, 0); PVM(1, 0); PVM(2, 0); PVM(3, 0); PVM(4, 1); PVM(5, 1); PVM(6, 1); PVM(7, 1);
      VRD(8); VRD(9); VRD(10); VRD(11); VRD(12); VRD(13); VRD(14); VRD(15);
      PVM(8, 2); PVM(9, 2); PVM(10, 2); PVM(11, 2); PVM(12, 3); PVM(13, 3); PVM(14, 3); PVM(15, 3); }
#undef STEP
#undef GAPA
#undef GAPB
#undef PVM
#undef VRD
#undef VFR
#undef PAF
#undef PKW
#undef PIN
#undef EX
#undef BAND
#undef DMA_K
#undef DMA_V
#undef DMA_K0
#undef DMA_K1
#undef DMA_V0
#undef DMA_V1
#undef TCL
#undef ROT
    { auto rr = __builtin_amdgcn_permlane32_swap(__float_as_uint(l_reg), __float_as_uint(l_reg), false, false); l_reg = __uint_as_float(rr[0]) + __uint_as_float(rr[1]); }
    if (hi == 0) wsf[r32] = l_reg;
    asm volatile("s_waitcnt lgkmcnt(0)" ::: "memory");
    float rl[16];
#pragma unroll
    for (int r = 0; r < 16; ++r) rl[r] = __builtin_amdgcn_rcpf(wsf[crow(r, hi)]) * (cmap ? lam : 1.0f);
    WAIT_BAR(0);
    const size_t gbase = (size_t)(rowbase + q0 + wq * 32) * DM + h * 128 + cmap * 64;
    u32x4 zq[4];
#pragma unroll
    for (int i = 0; i < 4; ++i) { const int pc = lane + 64 * i; zq[i] = __builtin_nontemporal_load((const u32x4*)(P.sz + gbase + (size_t)(pc >> 3) * DM + (pc & 7) * 8)); }
    if (has_next) {
        const int nt1 = (2 * nqb + 2 > 2) ? 2 : 1;
        const bf16_t* nk = P.k + (size_t)nbh * 64 * 8192 + (2 * wid) * 512 + lane * 8; const bf16_t* nv = P.v + (size_t)nbh * 64 * 8192 + (2 * wid) * 512 + lane * 8;
        glds16(nk, (unsigned)__builtin_amdgcn_readfirstlane(kdst)); glds16(nk + 512, (unsigned)__builtin_amdgcn_readfirstlane(kdst + 1024));
        glds16(nv, (unsigned)__builtin_amdgcn_readfirstlane(vdst)); glds16(nv + 512, (unsigned)__builtin_amdgcn_readfirstlane(vdst + 1024));
        glds16(nk + 8192, (unsigned)__builtin_amdgcn_readfirstlane(kdst + SLOTB)); glds16(nk + 8192 + 512, (unsigned)__builtin_amdgcn_readfirstlane(kdst + SLOTB + 1024));
        glds16(nk + (long)nt1 * 8192, (unsigned)__builtin_amdgcn_readfirstlane(kdst + 2 * SLOTB)); glds16(nk + (long)nt1 * 8192 + 512, (unsigned)__builtin_amdgcn_readfirstlane(kdst + 2 * SLOTB + 1024));
        const bf16_t* Qn = P.q + ((long)(nbh >> 3) * SEQ + nqb * 128 + wq * 32 + r32) * DM + (nbh & 7) * 128 + cmap * 64 + hi * 8;
#pragma unroll
        for (int d0 = 0; d0 < 4; ++d0) qr[d0] = *(const bf16x8*)(Qn + d0 * 16);
    }
    LAS float* ex = (LAS float*)(shm + LDS_EX) + wq * 4096;
    {
        LAS float* exs = ex + cmap * 2048;
#pragma unroll
        for (int e2 = 0; e2 < 2; ++e2)
#pragma unroll
            for (int r = 0; r < 16; ++r) exs[(e2 * 16 + r) * 64 + lane] = (cmap ? o[e2][r] : o[2 + e2][r]) * rl[r];
    }
    asm volatile("s_waitcnt lgkmcnt(0)\n\ts_barrier" ::: "memory");
    float vk[2][16], ssq[16];
    {   const LAS float* exr = ex + (cmap ^ 1) * 2048;
#pragma unroll
        for (int r = 0; r < 16; ++r) ssq[r] = 0.f;
#pragma unroll
        for (int e2 = 0; e2 < 2; ++e2)
#pragma unroll
            for (int r = 0; r < 16; ++r) { const float mine = (cmap ? o[2 + e2][r] : o[e2][r]) * rl[r], oth = exr[(e2 * 16 + r) * 64 + lane];
                const float v = cmap ? oth - mine : mine - oth; vk[e2][r] = v; ssq[r] += v * v; }
    }
#pragma unroll
    for (int r = 0; r < 16; ++r) ssq[r] = rowsum32(ssq[r]);
    if (r32 == 0) {
#pragma unroll
        for (int r = 0; r < 16; ++r) wsf[hi * 16 + r] = ssq[r];
    }
    asm volatile("s_waitcnt lgkmcnt(0)\n\ts_barrier" ::: "memory");
    { const LAS float* wsp = (const LAS float*)(shm + LDS_WSF) + (wid ^ 4) * 64 + hi * 16;
#pragma unroll
      for (int r = 0; r < 16; ++r) ssq[r] = rsqrtf((ssq[r] + wsp[r]) * (1.0f / 128.0f) + EPS) * (1.0f - LAM_INIT); }
#pragma unroll
    for (int e2 = 0; e2 < 2; ++e2) { const float gsub = P.subln[cmap * 64 + e2 * 32 + r32];
#pragma unroll
        for (int r = 0; r < 16; ++r) ex[crow(r, hi) * 128 + cmap * 64 + e2 * 32 + r32] = vk[e2][r] * ssq[r] * gsub; }
    asm volatile("s_waitcnt lgkmcnt(0)" ::: "memory");
#pragma unroll
    for (int i = 0; i < 4; ++i) { const int pc = lane + 64 * i; const LAS f32x4* sp = (const LAS f32x4*)(ex + (pc >> 3) * 128 + cmap * 64 + (pc & 7) * 8);
        f32x4 z0, z1; unpack8(zq[i], z0, z1);
        *(u32x4*)(P.og + gbase + (size_t)(pc >> 3) * DM + (pc & 7) * 8) = pack8(sp[0] * z0, sp[1] * z1); }
}
#undef SBAR
#undef WAIT_BAR

__device__ __forceinline__ void unit_of(int U, int vcu, int G, int& bh, int& qb) {
    if (G == 256) {
        const int k = U >> 8, x = vcu >> 5, c = vcu & 31; bh = x * 8 + k;
        qb = (k & 1) ? 31 - ((c + 4 * (k - 1)) & 31) : ((c + 4 * k) & 31);
    } else { bh = U >> 5; qb = U & 31; }
}
__device__ __forceinline__ void attn_phase(const Params& P, LAS unsigned char* shm, int vcu, int G) {
    LAS float* misc = (LAS float*)(shm + LDS_MISC);
    if (threadIdx.x < 64) {
        const int l = threadIdx.x;
        const float s1 = wave_sum(P.lq1[l] * P.lk1[l]), s2 = wave_sum(P.lq2[l] * P.lk2[l]);
        if (l == 0) misc[0] = expf(s1) - expf(s2) + LAM_INIT;
    }
    for (int e = threadIdx.x; e < 8 * 129; e += 512) { const int hh = e / 129, i = e - hh * 129, n = i - 1;
        ((LAS float*)(shm + LDS_BT))[hh * BT_STRIDE + i] = (i == 0) ? -INFINITY : (P.rel_bias[t5_bucket(n) * NH + hh] - P.rel_bias[31 * NH + hh]) * LOG2E; }
    __syncthreads();
    const float lam = misc[0];
    bool first = true; bf16x8 qr[4];
#pragma unroll
    for (int d0 = 0; d0 < 4; ++d0) qr[d0] = bf16x8{};
    if (__builtin_amdgcn_readfirstlane((int)(threadIdx.x >> 6)) >= 4) __builtin_amdgcn_s_setprio(1);
    for (int U = vcu; U < 2048; U += G) {
        int bh, qb, nbh = 0, nqb = 0; unit_of(U, vcu, G, bh, qb);
        const bool has_next = (U + G < 2048); if (has_next) unit_of(U + G, vcu, G, nbh, nqb);
        attn_unit(P, bh, qb, shm, lam, first, has_next, nbh, nqb, qr); first = false;
    }
    __builtin_amdgcn_s_setprio(0);
}
}

struct Args { const float* in[30]; float* out; unsigned char* ws; int ph_lo, ph_hi; };

constexpr int LDS_BYTES = 147456;

__device__ __forceinline__ void transpose_item(const float* W, int ldsrc, int scol0, const float* gain, bf16_t* WT, int K, int nrow0, int k0, LAS float* scr, int lane) {
    float wv[32];
#pragma unroll
    for (int i = 0; i < 32; ++i) wv[i] = W[(size_t)(k0 + 2 * i + (lane >> 5)) * ldsrc + scol0 + (lane & 31)];
#pragma unroll
    for (int i = 0; i < 32; ++i) { const int kk = 2 * i + (lane >> 5); float v = wv[i]; if (gain) v *= gain[k0 + kk]; scr[kk * 33 + (lane & 31)] = v; }
    asm volatile("s_waitcnt lgkmcnt(0)" ::: "memory");
    const int c = lane & 7;
#pragma unroll
    for (int j = 0; j < 4; ++j) { const int n = (lane >> 3) + 8 * j; const LAS float* s = scr + (8 * c) * 33 + n;
        u32x4 o; o.x = cvtpk(s[0 * 33], s[1 * 33]); o.y = cvtpk(s[2 * 33], s[3 * 33]); o.z = cvtpk(s[4 * 33], s[5 * 33]); o.w = cvtpk(s[6 * 33], s[7 * 33]);
        *(u32x4*)(WT + (size_t)(nrow0 + n) * K + k0 + 8 * c) = o; }
    asm volatile("s_waitcnt lgkmcnt(0)" ::: "memory");
}
__device__ __forceinline__ void cpow(float lr, float li, float dt, float n, float& re, float& im) { const float mag = __expf(lr * dt * n), ang = li * dt * n; re = mag * __cosf(ang); im = mag * __sinf(ang); }
__device__ __forceinline__ void zoh_f(float lr, float li, float dt, float& fr_, float& fi_) {
    const float x = lr * dt, y = li * dt, ex = __expf(x), sh = __sinf(0.5f * y);
    const float nr = expm1f(x) * __cosf(y) - 2.0f * sh * sh, ni = ex * __sinf(y), den = lr * lr + li * li;
    fr_ = (nr * lr + ni * li) / den; fi_ = (ni * lr - nr * li) / den;
}

__device__ __forceinline__ void prologue(const Args& a, LAS unsigned char* lds, int vcu, int G) {
    const int tid = threadIdx.x, lane = tid & 63, wave = __builtin_amdgcn_readfirstlane(tid >> 6);
    const int gw = vcu * 8 + wave, NGW = G * 8;
    unsigned char* ws = a.ws;
    const float *lam_re = a.in[4], *lam_im = a.in[5], *log_dt = a.in[6], *b_re = a.in[7], *b_im = a.in[8], *c_re = a.in[9], *c_im = a.in[10], *dvec = a.in[11];
    bf16_t* bts = (bf16_t*)(ws + WS_BTS); bf16_t* w1s = (bf16_t*)(ws + WS_W1S);
    constexpr int N_D3 = NG * TC, N_D1 = NG * TC, N_D2 = NG * TC, N_D4 = NG * TC, N_D5 = 64, TG = TC * GC, N_X = M / 8;
    constexpr int T_IN0 = 16 * 64, T_GLU = 16 * 64, T_SQ = 16 * 32, T_PRJ = 4 * 32, T_QKV = 16 * 128;
    constexpr int N_T = T_IN0 + T_GLU + 4 * T_SQ + 2 * T_PRJ + T_QKV;
    constexpr int O_D1 = N_D3, O_D2 = O_D1 + N_D1, O_D4 = O_D2 + N_D2, O_D5 = O_D4 + N_D4, O_T = O_D5 + N_D5, O_X = O_T + N_T, N_ALL = O_X + N_X;
    LAS float* scr = (LAS float*)(lds + wave * 16384);
    static_assert(N_ALL == 229 * 64, "item blocks");
    for (int it0 = gw; it0 < N_ALL; it0 += NGW) {
        const int it = ((((it0 >> 6) * 89) % 229) << 6) | (it0 & 63);
        if (it < O_D1) {
            const int g = it / TC, tau = it % TC; const float dt = __expf(log_dt[g]);
            { f32x4 ld[16];
              const f32x4* s0 = (const f32x4*)(c_re + (size_t)g * GC * NP) + lane; const f32x4* s1 = (const f32x4*)(c_im + (size_t)g * GC * NP) + lane;
              const f32x4* s2 = (const f32x4*)(b_re + (size_t)g * NP * GC) + lane; const f32x4* s3 = (const f32x4*)(b_im + (size_t)g * NP * GC) + lane;
#pragma unroll
              for (int i = 0; i < 4; ++i) { ld[i] = s0[64 * i]; ld[4 + i] = s1[64 * i]; ld[8 + i] = s2[64 * i]; ld[12 + i] = s3[64 * i]; }
#pragma unroll
              for (int a = 0; a < 4; ++a)
#pragma unroll
                for (int i = 0; i < 4; ++i) *(LAS f32x4*)(scr + a * 1024 + (lane + 64 * i) * 4) = ld[4 * a + i]; }
            float Gr, Gi;
            { const int p = lane; const float lr = lam_re[g * NP + p], li = lam_im[g * NP + p];
              float f_r, f_i, ar, ai; zoh_f(lr, li, dt, f_r, f_i); cpow(lr, li, dt, (float)tau, ar, ai);
              Gr = ar * f_r - ai * f_i; Gi = ar * f_i + ai * f_r; }
            asm volatile("s_waitcnt lgkmcnt(0)" ::: "memory");
            const int c = lane >> 2, q4 = (lane & 3) * 4;
            f32x4 kt = (f32x4){0.f, 0.f, 0.f, 0.f};
#pragma unroll
            for (int p0 = 0; p0 < NP; p0 += 4) {
                const f32x4 cr4 = *(const LAS f32x4*)(scr + c * NP + p0), ci4 = *(const LAS f32x4*)(scr + 1024 + c * NP + p0);
#pragma unroll
                for (int pp = 0; pp < 4; ++pp) { const int p = p0 + pp;
                    const float gr = __builtin_bit_cast(float, __builtin_amdgcn_readlane(__builtin_bit_cast(int, Gr), p)), gi = __builtin_bit_cast(float, __builtin_amdgcn_readlane(__builtin_bit_cast(int, Gi), p));
                    const float er = cr4[pp] * gr - ci4[pp] * gi, ei = cr4[pp] * gi + ci4[pp] * gr;
                    const f32x4 br = *(const LAS f32x4*)(scr + 2048 + p * GC + q4), bi = *(const LAS f32x4*)(scr + 3072 + p * GC + q4);
                    kt += er * br - ei * bi; }
            }
            if (tau == 0) {
#pragma unroll
                for (int j = 0; j < 4; ++j) if (q4 + j == c) kt[j] += dvec[g * GC + c];
            }
            const u32x2 w = (u32x2){cvtpk(kt[0], kt[1]), cvtpk(kt[2], kt[3])};
            for (int s = 0; s + tau < TC; ++s) *(u32x2*)(bts + ((size_t)g * TG + (s + tau) * GC + c) * KX + 128 + s * GC + q4) = w;
            asm volatile("s_waitcnt lgkmcnt(0)" ::: "memory");
        } else if (it < O_D2) {
            const int r = it - O_D1, g = r / TC, s = r % TC, p = lane; const float dt = __expf(log_dt[g]);
            const float lr = lam_re[g * NP + p], li = lam_im[g * NP + p];
            float f_r, f_i, ar, ai; zoh_f(lr, li, dt, f_r, f_i); cpow(lr, li, dt, (float)(TC - 1 - s), ar, ai);
            const float gr = ar * f_r - ai * f_i, gi = ar * f_i + ai * f_r;
            const float* br = b_re + (size_t)(g * NP + p) * GC; const float* bi = b_im + (size_t)(g * NP + p) * GC;
            float vr[16], vi[16];
#pragma unroll
            for (int j = 0; j < 16; ++j) { vr[j] = gr * br[j] - gi * bi[j]; vi[j] = gr * bi[j] + gi * br[j]; }
            bf16_t* dr = w1s + ((size_t)g * 128 + p) * TG + s * GC; bf16_t* di = dr + (size_t)64 * TG;
            *(u32x4*)dr = (u32x4){cvtpk(vr[0], vr[1]), cvtpk(vr[2], vr[3]), cvtpk(vr[4], vr[5]), cvtpk(vr[6], vr[7])};
            *(u32x4*)(dr + 8) = (u32x4){cvtpk(vr[8], vr[9]), cvtpk(vr[10], vr[11]), cvtpk(vr[12], vr[13]), cvtpk(vr[14], vr[15])};
            *(u32x4*)di = (u32x4){cvtpk(vi[0], vi[1]), cvtpk(vi[2], vi[3]), cvtpk(vi[4], vi[5]), cvtpk(vi[6], vi[7])};
            *(u32x4*)(di + 8) = (u32x4){cvtpk(vi[8], vi[9]), cvtpk(vi[10], vi[11]), cvtpk(vi[12], vi[13]), cvtpk(vi[14], vi[15])};
        } else if (it < O_D4) {
            const int r = it - O_D2, g = r / TC, t = r % TC, p = lane; const float dt = __expf(log_dt[g]);
            const float lr = lam_re[g * NP + p], li = lam_im[g * NP + p];
            float ar, ai; cpow(lr, li, dt, (float)(t + 1), ar, ai);
            float crv[GC], civ[GC];
#pragma unroll
            for (int c = 0; c < GC; ++c) { crv[c] = c_re[(g * GC + c) * NP + p]; civ[c] = c_im[(g * GC + c) * NP + p]; }
#pragma unroll
            for (int c = 0; c < GC; ++c) { const float cr = crv[c], ci = civ[c];
                bf16_t* d = bts + ((size_t)g * TG + t * GC + c) * KX; d[p] = f2bf(cr * ar - ci * ai); d[64 + p] = f2bf(-(cr * ai + ci * ar)); }
        } else if (it < O_D5) {
            const int r = it - O_D4, g = r / TC, t = r % TC; const int npc = (TC - 1 - t) * 2;
            for (int idx = lane; idx < GC * npc; idx += 64) { const int c = idx / npc, pc = idx - c * npc;
                *(u32x4*)(bts + ((size_t)g * TG + t * GC + c) * KX + 128 + (t + 1) * GC + pc * 8) = (u32x4){0u, 0u, 0u, 0u}; }
        } else if (it < O_T) {
            const int g = it - O_D5, p = lane; float ar, ai; cpow(lam_re[g * NP + p], lam_im[g * NP + p], __expf(log_dt[g]), (float)TC, ar, ai);
            float* at = (float*)(ws + WS_AT); at[(g * NP + p) * 2] = ar; at[(g * NP + p) * 2 + 1] = ai;
        } else if (it < O_X) {
            int r = it - O_T;
            if (r < T_IN0) { const int kb = r >> 6, nb = r & 63; transpose_item(a.in[3], 2048, 32 * nb, a.in[2], (bf16_t*)(ws + WS_W_IN0), 1024, 32 * nb, 64 * kb, scr, lane); continue; } r -= T_IN0;
            if (r < T_GLU) { const int kb = r >> 6, nb = r & 63, n0 = 32 * nb; transpose_item(a.in[12], 2048, ((n0 >> 7) & 1) * 1024 + 128 * (n0 >> 8) + (n0 & 127), nullptr, (bf16_t*)(ws + WS_W_GLU), 1024, n0, 64 * kb, scr, lane); continue; } r -= T_GLU;
            if (r < T_SQ) { transpose_item(a.in[13], 1024, 32 * (r & 31), nullptr, (bf16_t*)(ws + WS_W_OUT0), 1024, 32 * (r & 31), 64 * (r >> 5), scr, lane); continue; } r -= T_SQ;
            if (r < T_SQ) { transpose_item(a.in[29], 1024, 32 * (r & 31), nullptr, (bf16_t*)(ws + WS_W_GATE0), 1024, 32 * (r & 31), 64 * (r >> 5), scr, lane); continue; } r -= T_SQ;
            if (r < T_SQ) { transpose_item(a.in[26], 1024, 32 * (r & 31), nullptr, (bf16_t*)(ws + WS_W_OUT1), 1024, 32 * (r & 31), 64 * (r >> 5), scr, lane); continue; } r -= T_SQ;
            if (r < T_SQ) { transpose_item(a.in[29] + (size_t)DM * DM, 1024, 32 * (r & 31), nullptr, (bf16_t*)(ws + WS_W_GATE1), 1024, 32 * (r & 31), 64 * (r >> 5), scr, lane); continue; } r -= T_SQ;
            if (r < T_PRJ) { transpose_item(a.in[28], 1024, 32 * (r & 31), nullptr, (bf16_t*)(ws + WS_W_PROJ0), 256, 32 * (r & 31), 64 * (r >> 5), scr, lane); continue; } r -= T_PRJ;
            if (r < T_PRJ) { transpose_item(a.in[28] + (size_t)PLE * DM, 1024, 32 * (r & 31), nullptr, (bf16_t*)(ws + WS_W_PROJ1), 256, 32 * (r & 31), 64 * (r >> 5), scr, lane); continue; } r -= T_PRJ;
            { const int kb = r >> 7, nb = r & 127, n0 = 32 * nb, type = n0 >> 10, within = n0 & 1023;
              const int scol = 256 * (within >> 8) + 64 * ((within >> 5) & 3) + 32 * ((within >> 7) & 1);
              const float* src = type == 0 ? a.in[15] : (type == 1 ? a.in[16] : a.in[19]); const int ld = type < 2 ? 1024 : 2048;
              const float* gain = type < 2 ? a.in[14] : a.in[18];
              transpose_item(src, ld, scol + (type == 3 ? 1024 : 0), gain, (bf16_t*)(ws + WS_W_QKV), 1024, n0, 64 * kb, scr, lane); }
        } else {
            const int r0 = (it - O_X) * 8; float* ss0 = (float*)(ws + WS_SS0); bf16_t* xb = (bf16_t*)(ws + WS_XB);
            f32x4 v[8][2][2];
#pragma unroll
            for (int rr = 0; rr < 8; ++rr)
#pragma unroll
                for (int j = 0; j < 2; ++j) { const f32x4* xr = (const f32x4*)(a.in[0] + (size_t)(r0 + rr) * DM + (lane + 64 * j) * 8);
                    v[rr][j][0] = __builtin_nontemporal_load(xr); v[rr][j][1] = __builtin_nontemporal_load(xr + 1); }
#pragma unroll
            for (int rr = 0; rr < 8; ++rr) { const int row = r0 + rr; float s = 0.f;
#pragma unroll
                for (int j = 0; j < 2; ++j) { s += sumsq4(v[rr][j][0]) + sumsq4(v[rr][j][1]); *(u32x4*)(xb + (size_t)row * DM + (lane + 64 * j) * 8) = pack8(v[rr][j][0], v[rr][j][1]); }
                s = wave_sum(s); if (lane == 0) ss0[row] = s; }
        }
    }
}

__device__ __forceinline__ void convert_p(const float* p, bf16_t* pb, int layer, bool xl, int XI, int KR, int vcu, int G) {
    const int lane = threadIdx.x & 63, wave = __builtin_amdgcn_readfirstlane(threadIdx.x >> 6);
    const int first = xl ? (16 * XI + (KR & 7) + 8 * (wave >> 2)) * 16 + (KR >> 3) * 4 + (wave & 3) : vcu * 8 + wave, step = xl ? 2048 : G * 8, lim = 2048;
    for (int it = first; it < lim; it += step) {
        const size_t e0 = (size_t)layer * M * PLE + (size_t)it * 4096; const float* sp = p + e0; bf16_t* dp = pb + e0;
        f32x4 v[8][2];
#pragma unroll
        for (int j = 0; j < 8; ++j) { const f32x4* q = (const f32x4*)(sp + (lane + 64 * j) * 8); v[j][0] = __builtin_nontemporal_load(q); v[j][1] = __builtin_nontemporal_load(q + 1); }
#pragma unroll
        for (int j = 0; j < 8; ++j) *(u32x4*)(dp + (lane + 64 * j) * 8) = pack8(v[j][0], v[j][1]);
    }
}

__device__ __forceinline__ void ssm_state_phase(const bf16_t* aext, const bf16_t* w1s, float* S, int vcu, int G) {
    const int lane = threadIdx.x & 63, r32 = lane & 31, hi = lane >> 5, w = __builtin_amdgcn_readfirstlane(threadIdx.x >> 6);
    for (int unit = vcu; unit < 512; unit += G) {
        const int g = unit >> 3, cb = (unit & 7) * 256 + w * 32;
        const bf16_t* arow = aext + ((size_t)(g * NCHUNK + cb + r32)) * KX + 128 + 8 * hi;
        const bf16_t* brow = w1s + ((size_t)g * 128 + r32) * (TC * GC) + 8 * hi;
        f32x16 acc[4];
#pragma unroll
        for (int n = 0; n < 4; ++n) acc[n] = f32x16{};
#pragma unroll 8
        for (int kk = 0; kk < TC * GC / 16; ++kk) {
            const bf16x8 av = *(const bf16x8*)(arow + 16 * kk);
#pragma unroll
            for (int n = 0; n < 4; ++n) { const bf16x8 bv = *(const bf16x8*)(brow + (size_t)n * 32 * (TC * GC) + 16 * kk); acc[n] = __builtin_amdgcn_mfma_f32_32x32x16_bf16(av, bv, acc[n], 0, 0, 0); }
        }
#pragma unroll
        for (int n = 0; n < 4; ++n)
#pragma unroll
            for (int r = 0; r < 16; ++r) S[((size_t)(g * NCHUNK + cb + att::crow(r, hi))) * 128 + n * 32 + r32] = acc[n][r];
    }
}
__device__ __forceinline__ void ssm_scan_phase(const float* S, const float* at, bf16_t* aext, int vcu, int G) {
    const int tid = threadIdx.x;
    if (tid >= 128) return;
    for (int item = vcu; item < 256; item += G) {
        const int idx = item * 128 + tid, p = idx & 63, g = (idx >> 6) & 63, b = idx >> 12;
        const float ar = at[(g * NP + p) * 2], ai = at[(g * NP + p) * 2 + 1]; float hr = 0.f, hi_ = 0.f;
        const size_t base0 = (size_t)g * NCHUNK + (size_t)b * NCK;
        for (int ck0 = 0; ck0 < NCK; ck0 += 32) {
            float sr[32], si[32];
#pragma unroll
            for (int i = 0; i < 32; ++i) { sr[i] = S[(base0 + ck0 + i) * 128 + p]; si[i] = S[(base0 + ck0 + i) * 128 + 64 + p]; }
#pragma unroll
            for (int i = 0; i < 32; ++i) {
                aext[(base0 + ck0 + i) * KX + p] = f2bf(hr); aext[(base0 + ck0 + i) * KX + 64 + p] = f2bf(hi_);
                const float nr = ar * hr - ai * hi_ + sr[i], ni = ar * hi_ + ai * hr + si[i]; hr = nr; hi_ = ni;
            }
        }
    }
}


__device__ __forceinline__ void ssm_state_scan_fused(const bf16_t* aext_c, const bf16_t* w1s, const float* at, bf16_t* aext, LAS unsigned char* lds, int vcu, bool xl, int XI, int KR) {
    const int tid = threadIdx.x, lane = tid & 63, r32 = lane & 31, hi = lane >> 5, w = __builtin_amdgcn_readfirstlane(tid >> 6);
    LAS float* Sl = (LAS float*)lds;
    LAS float* Eb = (LAS float*)(lds + 256 * 129 * 4);
#pragma unroll 1
    for (int ui = 0; ui < 2; ++ui) {
        const int L = vcu + 256 * ui, g = xl ? KR * 2 + ui : L >> 3, cb0 = (xl ? XI : (L & 7)) * NCK;
        {
            const bf16_t* wg = w1s + (size_t)g * 128 * (TC * GC);
#pragma unroll
            for (int j = 0; j < 8; ++j) { const int q = j * 512 + tid, row = q >> 5, kg = (q & 31) ^ (row & 31);
                __builtin_amdgcn_global_load_lds((const unsigned*)(wg + (size_t)row * (TC * GC) + kg * 8), (LAS unsigned*)(lds + j * 8192 + w * 1024), 16, 0, 0); }
            const int cb = cb0 + w * 32;
            const bf16_t* arow = aext_c + ((size_t)(g * NCHUNK + cb + r32)) * KX + 128 + 8 * hi;
            f32x16 acc[4];
#pragma unroll
            for (int n = 0; n < 4; ++n) acc[n] = f32x16{};
            asm volatile("s_waitcnt vmcnt(0)" ::: "memory");
            __syncthreads();
#pragma unroll 8
            for (int kk = 0; kk < TC * GC / 16; ++kk) {
                const bf16x8 av = *(const bf16x8*)(arow + 16 * kk);
#pragma unroll
                for (int n = 0; n < 4; ++n) { const bf16x8 bv = *(const LAS bf16x8*)(lds + ((n * 32 + r32) * 32 + ((2 * kk + hi) ^ r32)) * 16); acc[n] = __builtin_amdgcn_mfma_f32_32x32x16_bf16(av, bv, acc[n], 0, 0, 0); }
            }
            __syncthreads();
#pragma unroll
            for (int n = 0; n < 4; ++n)
#pragma unroll
                for (int r = 0; r < 16; ++r) Sl[(w * 32 + att::crow(r, hi)) * 129 + n * 32 + r32] = acc[n][r];
        }
        __syncthreads();
        const int p = tid & 63, seg = __builtin_amdgcn_readfirstlane(tid >> 6);
        float ar = 0.f, ai = 0.f;
        LAS float* sp = Sl + (seg * 64) * 129 + p;
        if (tid < 256) {
            ar = at[(g * NP + p) * 2]; ai = at[(g * NP + p) * 2 + 1]; float hr = 0.f, hi_ = 0.f;
#pragma unroll 8
            for (int ck = 0; ck < 64; ++ck) { const float sr = sp[ck * 129], si = sp[ck * 129 + 64]; const float nr = ar * hr - ai * hi_ + sr, ni = ar * hi_ + ai * hr + si; hr = nr; hi_ = ni; }
            Eb[(seg * 64 + p) * 2] = hr; Eb[(seg * 64 + p) * 2 + 1] = hi_;
        }
        __syncthreads();
        if (tid < 256) {
            float qr = ar, qi = ai;
#pragma unroll
            for (int k = 0; k < 6; ++k) { const float nr = qr * qr - qi * qi, ni = 2.f * qr * qi; qr = nr; qi = ni; }
            float hr = 0.f, hi_ = 0.f;
            for (int sg = 0; sg < seg; ++sg) { const float er = Eb[(sg * 64 + p) * 2], ei = Eb[(sg * 64 + p) * 2 + 1]; const float nr = qr * hr - qi * hi_ + er, ni = qr * hi_ + qi * hr + ei; hr = nr; hi_ = ni; }
#pragma unroll 8
            for (int ck = 0; ck < 64; ++ck) {
                const float sr = sp[ck * 129], si = sp[ck * 129 + 64];
                ((LAS unsigned*)sp)[ck * 129] = (unsigned)f2bf(hr) | ((unsigned)f2bf(hi_) << 16);
                const float nr = ar * hr - ai * hi_ + sr, ni = ar * hi_ + ai * hr + si; hr = nr; hi_ = ni;
            }
        }
        __syncthreads();
        {
            for (int pc = tid; pc < 256 * 16; pc += 512) { const int row = pc >> 4, j = pc & 15, isim = j >> 3, p0 = (j & 7) * 8;
                const LAS unsigned* wp = (const LAS unsigned*)Sl + row * 129 + p0;
                unsigned v[8];
#pragma unroll
                for (int e = 0; e < 8; ++e) v[e] = isim ? (wp[e] >> 16) : (wp[e] & 0xffffu);
                u32x4 o; o.x = v[0] | (v[1] << 16); o.y = v[2] | (v[3] << 16); o.z = v[4] | (v[5] << 16); o.w = v[6] | (v[7] << 16);
                *(u32x4*)(aext + ((size_t)g * NCHUNK + cb0 + row) * KX + isim * 64 + p0) = o; }
            asm volatile("s_waitcnt vmcnt(0)" ::: "memory");
        }
        __syncthreads();
    }
}

#ifndef USE_CG_SYNC
#define USE_CG_SYNC 0
#endif
#define XB_TMO      128
#define XB_XCNT(j)  (256  + 64 * (j))
#define XB_XSUB(j)  (1280 + 64 * (j))
#define XB_XGEN(j)  (2304 + 64 * (j))
#define XB_TOP      3328
#define XB_TOPGEN   3392
#define XB_GCNT(j, g) (3520 + 64 * (j) + (g))
#define XCD_BAR_WORDS 4544
#define XB_SPIN_CAP (1u << 20)
__device__ __forceinline__ unsigned xb_ld(unsigned* p)              { return __hip_atomic_load(p, __ATOMIC_RELAXED, __HIP_MEMORY_SCOPE_AGENT); }
__device__ __forceinline__ unsigned xb_add(unsigned* p, unsigned v) { return __hip_atomic_fetch_add(p, v, __ATOMIC_RELAXED, __HIP_MEMORY_SCOPE_AGENT); }
__device__ __forceinline__ unsigned xb_xcc_id() { return (unsigned)__builtin_amdgcn_s_getreg((3 << 11) | 20) & 0xFu; }
#define XB_SPIN(cond, bar) do { unsigned _sp = 0; while (cond) { __builtin_amdgcn_s_sleep(1); \
    if ((++_sp & 255u) == 0u) { if (xb_ld(&(bar)[XB_TMO])) break; if (_sp > XB_SPIN_CAP) { atomicAdd(&(bar)[XB_TMO], 1u); break; } } } } while (0)
struct XcdBarrier { unsigned* bar; unsigned x; volatile LAS unsigned* st; };
__device__ __forceinline__ XcdBarrier xcd_barrier_post(unsigned* bar, volatile LAS unsigned* st) {
    XcdBarrier b; b.bar = bar; b.x = xb_xcc_id(); b.st = st;
    if (threadIdx.x == 0) st[2] = xb_add(&bar[XB_XCNT(b.x)], 1u);
    return b;
}
__device__ __forceinline__ void xcd_barrier_complete(unsigned* bar, unsigned x, unsigned& nloc, unsigned& nx) {
    const unsigned G = gridDim.x * gridDim.y * gridDim.z;
    unsigned sum, cnt, mine, sp = 0u;
    for (;;) {
        sum = 0u; cnt = 0u; mine = 0u;
#pragma unroll
        for (unsigned j = 0; j < 16; ++j) { const unsigned c = xb_ld(&bar[XB_XCNT(j)]); sum += c; cnt += (c > 0u) ? 1u : 0u; mine = (j == x) ? c : mine; }
        if (sum == G) break;
        __builtin_amdgcn_s_sleep(1);
        if ((++sp & 255u) == 0u) { if (xb_ld(&bar[XB_TMO])) break; if (sp > XB_SPIN_CAP) { atomicAdd(&bar[XB_TMO], 1u); break; } }
    }
    nloc = mine > 0u ? mine : 1u; nx = cnt > 0u ? cnt : 1u;
}
__device__ __forceinline__ void xcd_census_shape(unsigned* bar, unsigned x, unsigned& xidx, unsigned& regular) {
    unsigned idx = 0u, npop = 0u, ok = 1u;
#pragma unroll
    for (unsigned j = 0; j < 16; ++j) { const unsigned c = xb_ld(&bar[XB_XCNT(j)]); if (c > 0u) { npop++; if (j < x) idx++; if (c != 32u) ok = 0u; } }
    xidx = idx; regular = (ok && npop == 8u) ? 1u : 0u;
}
__device__ __forceinline__ void xcd_barrier(const XcdBarrier& b, bool local_only = false) {
    asm volatile("s_waitcnt vmcnt(0)" ::: "memory");
    __syncthreads();
    if (threadIdx.x == 0) {
        unsigned* bar = b.bar;
        __builtin_amdgcn_s_waitcnt(0);
        unsigned nloc = b.st[0], nx = b.st[1];
        if (nloc == 0u) { xcd_barrier_complete(bar, b.x, nloc, nx); unsigned xi, rg; xcd_census_shape(bar, b.x, xi, rg); b.st[3] = xi; b.st[4] = rg; b.st[0] = nloc; b.st[1] = nx; }
        const unsigned old = xb_add(&bar[XB_XSUB(b.x)], 1u);
        const unsigned gen = old / nloc;
        if (old + 1u == (gen + 1u) * nloc) {
            if (!local_only) {
            __builtin_amdgcn_fence(__ATOMIC_RELEASE, "agent");
            asm volatile("s_waitcnt vmcnt(0)" ::: "memory");
            const unsigned og = xb_add(&bar[XB_TOP], 1u);
            const unsigned tg = og / nx;
            if (og + 1u == (tg + 1u) * nx) xb_add(&bar[XB_TOPGEN], 1u);
            else XB_SPIN(xb_ld(&bar[XB_TOPGEN]) == tg, bar);
            }
            __builtin_amdgcn_fence(__ATOMIC_ACQUIRE, "agent");
            xb_add(&bar[XB_XGEN(b.x)], 1u);
            asm volatile("s_waitcnt vmcnt(0)" ::: "memory");
        } else {
            XB_SPIN(xb_ld(&bar[XB_XGEN(b.x)]) == gen, bar);
            __builtin_amdgcn_fence(__ATOMIC_ACQUIRE, "agent");
            asm volatile("s_waitcnt vmcnt(0)" ::: "memory");
        }
    }
    __syncthreads();
}
__device__ __forceinline__ void xcd_barrier_local_arrive(const XcdBarrier& b) {
    asm volatile("s_waitcnt vmcnt(0)" ::: "memory");
    __syncthreads();
    if (threadIdx.x == 0) {
        unsigned* bar = b.bar;
        __builtin_amdgcn_s_waitcnt(0);
        const unsigned nloc = b.st[0];
        const unsigned old = xb_add(&bar[XB_XSUB(b.x)], 1u);
        const unsigned gen = old / nloc;
        if (old + 1u == (gen + 1u) * nloc) { xb_add(&bar[XB_XGEN(b.x)], 1u); b.st[5] = 0xffffffffu; }
        else b.st[5] = gen;
    }
}
__device__ __forceinline__ void xcd_barrier_local_wait(const XcdBarrier& b) {
    if (threadIdx.x == 0) {
        unsigned* bar = b.bar;
        const unsigned gen = b.st[5];
        if (gen != 0xffffffffu) XB_SPIN(xb_ld(&bar[XB_XGEN(b.x)]) == gen, bar);
        __builtin_amdgcn_fence(__ATOMIC_ACQUIRE, "agent");
        asm volatile("s_waitcnt vmcnt(0)" ::: "memory");
    }
    __syncthreads();
}
__device__ __forceinline__ void grp_barrier(const XcdBarrier& b, int g) {
    asm volatile("s_waitcnt vmcnt(0)" ::: "memory");
    __syncthreads();
    if (threadIdx.x == 0) {
        unsigned* c = &b.bar[XB_GCNT(b.x, g)];
        __builtin_amdgcn_s_waitcnt(0);
        const unsigned old = xb_add(c, 1u);
        const unsigned target = (old / 4u + 1u) * 4u;
        XB_SPIN(xb_ld(c) < target, b.bar);
        __builtin_amdgcn_fence(__ATOMIC_ACQUIRE, "agent");
        asm volatile("s_waitcnt vmcnt(0)" ::: "memory");
    }
    __syncthreads();
}
constexpr int LDS_XB_OFF = 140 * 1024;
constexpr size_t CTL_ZERO_BYTES = 65536;

__global__ void __launch_bounds__(512, 2) fwd_kernel(Args args) {
    extern __shared__ __attribute__((aligned(16))) unsigned char lds_raw[];
    LAS unsigned char* lds = (LAS unsigned char*)lds_raw;
    const int G = gridDim.x, bx = blockIdx.x;
    const int vcu = (G % 8 == 0) ? (bx % 8) * (G / 8) + bx / 8 : bx;
    unsigned char* ws = args.ws;
    const int lo = args.ph_lo, hi = args.ph_hi;
#define IN(k) (lo <= (k) && (k) < hi)
#if USE_CG_SYNC
#define SEAM(k) do { if (IN(k) && IN((k) + 1)) { cg::this_grid().sync(); } } while (0)
#else
    XcdBarrier bar; bar.bar = (unsigned*)ws + 1024; bar.x = 0; bar.st = nullptr;
    if (hi - lo > 1) {
        volatile LAS unsigned* st = (volatile LAS unsigned*)(lds + LDS_XB_OFF);
        if (threadIdx.x < 8) st[threadIdx.x] = 0u;
        __syncthreads();
        bar = xcd_barrier_post((unsigned*)ws + 1024, st);
    }
#define SEAM(k) do { if (IN(k) && IN((k) + 1)) { xcd_barrier(bar); } } while (0)
#endif
    float* xs = args.out;
    if (IN(0)) { prologue(args, lds, vcu, G); }
    SEAM(0);
#if !USE_CG_SYNC
    const bool xl = (hi - lo > 1) && lo == 0 && hi >= 12 && G == 256 && __builtin_amdgcn_readfirstlane((int)bar.st[4]) != 0;
    const int XI = xl ? __builtin_amdgcn_readfirstlane((int)bar.st[3]) : 0, KR = xl ? (__builtin_amdgcn_readfirstlane((int)bar.st[2]) & 31) : 0;
#define SEAMX(k) do { if (IN(k) && IN((k) + 1)) { xcd_barrier(bar, xl); } } while (0)
#define SEAMG(k) do { if (IN(k) && IN((k) + 1)) { if (xl) grp_barrier(bar, KR & 7); else xcd_barrier(bar); } } while (0)
#else
    const bool xl = false; const int XI = 0, KR = 0;
#define SEAMX(k) SEAM(k)
#define SEAMG(k) SEAM(k)
#endif
    if (IN(1)) {
        { pg8::Gemm g{(const bf16_t*)(ws + WS_XB), (const bf16_t*)(ws + WS_W_IN0), DM, DM}; pg8::DualOrder S; S.init(M, 2048, DM, G, bx, xl, XI, KR);
          const LAS float* rl_ = nullptr; if (xl) { pg8::row_scales1_to_lds((const float*)(ws + WS_SS0), 16 * XI + (KR & 7), (LAS float*)(lds + pg8::LDS_RS_OFF)); rl_ = (const LAS float*)(lds + pg8::LDS_RS_OFF); }
          pg8::EpiInProj E{(const float*)(ws + WS_SS0), (bf16_t*)(ws + WS_AEXT), (bf16_t*)(ws + WS_SZ0), rl_};
          pg8::gemm_phase<pg8::EpiInProj, pg8::DualOrder, true>(lds, g, S, E); }
    }
    SEAMX(1);
    const bool ssm_fused = (G == 256) && IN(2) && IN(3) && IN(4);
    if (ssm_fused) ssm_state_scan_fused((const bf16_t*)(ws + WS_AEXT), (const bf16_t*)(ws + WS_W1S), (const float*)(ws + WS_AT), (bf16_t*)(ws + WS_AEXT), lds, vcu, xl, XI, KR);
    else {
    if (IN(2)) ssm_state_phase((const bf16_t*)(ws + WS_AEXT), (const bf16_t*)(ws + WS_W1S), (float*)(ws + WS_S), vcu, G);
    SEAM(2);
    if (IN(3)) ssm_scan_phase((const float*)(ws + WS_S), (const float*)(ws + WS_AT), (bf16_t*)(ws + WS_AEXT), vcu, G);
    SEAM(3);
    }
    if (IN(4)) { pg8::Gemm g{(const bf16_t*)(ws + WS_AEXT), (const bf16_t*)(ws + WS_BTS), KX, KX}; pg8::SsmOrder S{G, vcu, xl, XI, KR};
        pg8::EpiY E{(bf16_t*)(ws + WS_YB)}; pg8::gemm_phase<pg8::EpiY, pg8::SsmOrder, true>(lds, g, S, E); }
    if (xl && IN(4) && IN(5)) { xcd_barrier_local_arrive(bar); convert_p(args.in[1], (bf16_t*)(ws + WS_PB), 0, xl, XI, KR, vcu, G); xcd_barrier_local_wait(bar); }
    else { SEAMX(4); if (IN(5)) convert_p(args.in[1], (bf16_t*)(ws + WS_PB), 0, xl, XI, KR, vcu, G); }
    if (IN(5)) { pg8::Gemm g{(const bf16_t*)(ws + WS_YB), (const bf16_t*)(ws + WS_W_GLU), M, DM}; pg8::DualOrder S; S.init(M, 2048, DM, G, bx, xl, XI, KR);
        pg8::EpiGlu E{(const bf16_t*)(ws + WS_SZ0), (bf16_t*)(ws + WS_GB)}; pg8::gemm_phase<pg8::EpiGlu, pg8::DualOrder, true, 1>(lds, g, S, E); }
    SEAMG(5);
    const bool pflip = xl && (XI & 1);
    if (IN(6) && (pflip || !xl)) { pg8::Gemm g{(const bf16_t*)(ws + WS_PB), (const bf16_t*)(ws + WS_W_PROJ0), PLE, PLE}; pg8::DualOrder S; S.init(M, DM, PLE, G, bx, xl, XI, KR);
        pg8::EpiStore E{(bf16_t*)(ws + WS_PP0)}; pg8::gemm_phase<pg8::EpiStore, pg8::DualOrder, true>(lds, g, S, E); }
    if (IN(6)) { pg8::Gemm g{(const bf16_t*)(ws + WS_GB), (const bf16_t*)(ws + WS_W_OUT0), DM, DM}; pg8::DualOrder S; S.init(M, DM, DM, G, bx, xl, XI, KR);
        pg8::EpiOutRes<true, false> E{nullptr, (const bf16_t*)(ws + WS_XB), (bf16_t*)(ws + WS_X1B), (float*)(ws + WS_SSP1)}; pg8::gemm_phase<pg8::EpiOutRes<true, false>, pg8::DualOrder, true, 3>(lds, g, S, E); }
    if (IN(6) && xl && !pflip) { pg8::Gemm g{(const bf16_t*)(ws + WS_PB), (const bf16_t*)(ws + WS_W_PROJ0), PLE, PLE}; pg8::DualOrder S; S.init(M, DM, PLE, G, bx, xl, XI, KR);
        pg8::EpiStore E{(bf16_t*)(ws + WS_PP0)}; pg8::gemm_phase<pg8::EpiStore, pg8::DualOrder, true>(lds, g, S, E); }
    SEAMG(6);
    if (IN(7)) { pg8::Gemm g{(const bf16_t*)(ws + WS_X1B), (const bf16_t*)(ws + WS_W_GATE0), DM, DM}; pg8::DualOrder S; S.init(M, DM, DM, G, bx, xl, XI, KR);
        const LAS float* rl_ = nullptr; if (xl) { pg8::row_scales_to_lds((const float*)(ws + WS_SSP1), 16 * XI + (KR & 7), (LAS float*)(lds + pg8::LDS_RS_OFF)); rl_ = (const LAS float*)(lds + pg8::LDS_RS_OFF); }
        pg8::EpiGate<false> E{(const bf16_t*)(ws + WS_X1B), (const bf16_t*)(ws + WS_PP0), (const float*)(ws + WS_SSP1), (bf16_t*)(ws + WS_X2B), (float*)(ws + WS_SSP2), nullptr, rl_};
        pg8::gemm_phase<pg8::EpiGate<false>, pg8::DualOrder, true, 3>(lds, g, S, E); }
    SEAMG(7);
    if (IN(8)) { pg8::Gemm g{(const bf16_t*)(ws + WS_X2B), (const bf16_t*)(ws + WS_W_QKV), DM, DM}; pg8::DualOrder S; S.init(M, 4096, DM, G, bx, xl, XI, KR);
        const LAS float* rl_ = nullptr; if (xl) { pg8::row_scales_to_lds((const float*)(ws + WS_SSP2), 16 * XI + (KR & 7), (LAS float*)(lds + pg8::LDS_RS_OFF)); rl_ = (const LAS float*)(lds + pg8::LDS_RS_OFF); }
        pg8::EpiQKV E{(const float*)(ws + WS_SSP2), args.in[17], args.in[20], (bf16_t*)(ws + WS_K), (bf16_t*)(ws + WS_V), (bf16_t*)(ws + WS_Q), (bf16_t*)(ws + WS_SZ1), 0.125f * LOG2E, rl_};
        pg8::gemm_phase<pg8::EpiQKV, pg8::DualOrder, true, 3>(lds, g, S, E); }
    if (xl && IN(8) && IN(9)) { xcd_barrier_local_arrive(bar); convert_p(args.in[1], (bf16_t*)(ws + WS_PB), 1, xl, XI, KR, vcu, G); xcd_barrier_local_wait(bar); }
    else { SEAMX(8); if (IN(9)) convert_p(args.in[1], (bf16_t*)(ws + WS_PB), 1, xl, XI, KR, vcu, G); }
    if (IN(9)) { att::Params P{(const bf16_t*)(ws + WS_Q), (const bf16_t*)(ws + WS_K), (const bf16_t*)(ws + WS_V), (const bf16_t*)(ws + WS_SZ1), (bf16_t*)(ws + WS_OG),
                               args.in[27], args.in[20], args.in[17], args.in[21], args.in[22], args.in[23], args.in[24], args.in[25]};
        att2::attn_phase(P, lds, xl ? XI * 32 + KR : vcu, G); }
    SEAMX(9);
    if (IN(10) && (pflip || !xl)) { pg8::Gemm g{(const bf16_t*)(ws + WS_PB) + (size_t)M * PLE, (const bf16_t*)(ws + WS_W_PROJ1), PLE, PLE}; pg8::DualOrder S; S.init(M, DM, PLE, G, bx, xl, XI, KR);
        pg8::EpiStore E{(bf16_t*)(ws + WS_PP1)}; pg8::gemm_phase<pg8::EpiStore, pg8::DualOrder, true>(lds, g, S, E); }
    if (IN(10)) { pg8::Gemm g{(const bf16_t*)(ws + WS_OG), (const bf16_t*)(ws + WS_W_OUT1), DM, DM}; pg8::DualOrder S; S.init(M, DM, DM, G, bx, xl, XI, KR);
        pg8::EpiOutRes<true> E{nullptr, (const bf16_t*)(ws + WS_X2B), (bf16_t*)(ws + WS_X3B), (float*)(ws + WS_SSP3)}; pg8::gemm_phase<pg8::EpiOutRes<true>, pg8::DualOrder, true>(lds, g, S, E); }
    if (IN(10) && xl && !pflip) { pg8::Gemm g{(const bf16_t*)(ws + WS_PB) + (size_t)M * PLE, (const bf16_t*)(ws + WS_W_PROJ1), PLE, PLE}; pg8::DualOrder S; S.init(M, DM, PLE, G, bx, xl, XI, KR);
        pg8::EpiStore E{(bf16_t*)(ws + WS_PP1)}; pg8::gemm_phase<pg8::EpiStore, pg8::DualOrder, true>(lds, g, S, E); }
    SEAMG(10);
    if (IN(11)) { pg8::Gemm g{(const bf16_t*)(ws + WS_X3B), (const bf16_t*)(ws + WS_W_GATE1), DM, DM}; pg8::DualOrder S; S.init(M, DM, DM, G, bx, xl, XI, KR);
        const LAS float* rl_ = nullptr; if (xl) { pg8::row_scales_to_lds((const float*)(ws + WS_SSP3), 16 * XI + (KR & 7), (LAS float*)(lds + pg8::LDS_RS_OFF)); rl_ = (const LAS float*)(lds + pg8::LDS_RS_OFF); }
        pg8::EpiGate<true> E{(const bf16_t*)(ws + WS_X3B), (const bf16_t*)(ws + WS_PP1), (const float*)(ws + WS_SSP3), nullptr, nullptr, xs, rl_};
        pg8::gemm_phase<pg8::EpiGate<true>, pg8::DualOrder, true, 3>(lds, g, S, E); }
#undef SEAMX
#undef SEAMG
#undef IN
#undef SEAM
}

extern "C" void kernel_launch(void* const* d_in, const int* in_sizes, int n_in, void* d_out, int out_size, void* d_ws, size_t ws_size, hipStream_t stream) {
    static int grid = 0;
    if (grid == 0) {
        if (n_in != 30 || in_sizes[0] != M * DM || out_size != M * DM || ws_size < WS_END) { fprintf(stderr, "kernel_launch: unexpected shapes (n_in %d, in0 %d, out %d, ws %zu)\n", n_in, n_in > 0 ? in_sizes[0] : -1, out_size, ws_size); grid = -1; return; }
        int dev = 0, cus = 0, per_cu = 0;
        if (hipGetDevice(&dev) != hipSuccess || hipDeviceGetAttribute(&cus, hipDeviceAttributeMultiprocessorCount, dev) != hipSuccess) { grid = -1; return; }
        if (hipFuncSetAttribute((const void*)fwd_kernel, hipFuncAttributeMaxDynamicSharedMemorySize, LDS_BYTES) != hipSuccess) { fprintf(stderr, "kernel_launch: hipFuncSetAttribute failed\n"); grid = -1; return; }
        if (hipOccupancyMaxActiveBlocksPerMultiprocessor(&per_cu, (const void*)fwd_kernel, 512, LDS_BYTES) != hipSuccess || per_cu < 1) { fprintf(stderr, "kernel_launch: occupancy query failed (%d)\n", per_cu); (void)hipGetLastError(); grid = -1; return; }
        grid = cus * 1;
        fprintf(stderr, "kernel_launch: grid %d (cus %d, per_cu %d)\n", grid, cus, per_cu);
    }
    if (grid < 0) return;
    Args a{};
    for (int i = 0; i < 30; ++i) a.in[i] = (const float*)d_in[i];
    a.out = (float*)d_out; a.ws = (unsigned char*)d_ws;
#if MK_N_LAUNCHES == 1
    a.ph_lo = 0; a.ph_hi = 12;
#if !USE_CG_SYNC
    if (hipMemsetAsync(d_ws, 0, CTL_ZERO_BYTES, stream) != hipSuccess) { fprintf(stderr, "kernel_launch: hipMemsetAsync failed\n"); return; }
#endif
    void* kargs[] = {&a};
    hipError_t e = hipLaunchCooperativeKernel((const void*)fwd_kernel, dim3(grid), dim3(512), kargs, LDS_BYTES, stream);
    if (e != hipSuccess) fprintf(stderr, "kernel_launch: cooperative launch failed: %s (grid %d)\n", hipGetErrorString(e), grid);
#else
    for (int ph = 0; ph < 12; ++ph) { a.ph_lo = ph; a.ph_hi = ph + 1;
        for (int rep = 0; rep < 1 + ((PROBE_MASK >> ph) & 1); ++rep) hipLaunchKernelGGL(fwd_kernel, dim3(grid), dim3(512), LDS_BYTES, stream, a); }
#endif
}
```

```cpp
#include <hip/hip_runtime.h>
#include <hip/hip_cooperative_groups.h>
#include <cstdio>
#include <cstdint>
#include <cmath>
namespace cg = cooperative_groups;

#ifndef MK_N_LAUNCHES
#define MK_N_LAUNCHES 1
#endif

#ifndef PROBE_MASK
#define PROBE_MASK 0
#endif

#define LAS __attribute__((address_space(3)))
typedef unsigned short bf16_t;
typedef short bf16x8 __attribute__((ext_vector_type(8)));
typedef short s16x4 __attribute__((ext_vector_type(4)));
typedef float f32x2 __attribute__((ext_vector_type(2)));
typedef float f32x4 __attribute__((ext_vector_type(4)));
typedef float f32x16 __attribute__((ext_vector_type(16)));
typedef unsigned u32x2 __attribute__((ext_vector_type(2)));
typedef unsigned u32x4 __attribute__((ext_vector_type(4)));
typedef __bf16 bf16x2_t __attribute__((ext_vector_type(2)));

constexpr int BATCH = 8, SEQ = 4096, DM = 1024, M = BATCH * SEQ, PLE = 256;
constexpr int NG = 64, GC = 16, NP = 64, TC = 16, NCK = SEQ / TC, NCHUNK = BATCH * NCK;
constexpr int KX = 128 + TC * GC;
constexpr int NH = 8;
constexpr float EPS = 1e-6f;
constexpr float LOG2E = 1.4426950408889634f;
constexpr float LAM_INIT = 0.35550906759096926f;

constexpr size_t MiB = 1u << 20;
constexpr size_t WS_SS0 = 1 * MiB, WS_SSP1 = 2 * MiB, WS_SSP2 = 4 * MiB, WS_SSP3 = 6 * MiB, WS_AT = 8 * MiB;
constexpr size_t WS_W_IN0 = 9 * MiB, WS_W_GLU = 13 * MiB, WS_W_OUT0 = 17 * MiB, WS_W_GATE0 = 19 * MiB, WS_W_QKV = 21 * MiB, WS_W_OUT1 = 29 * MiB, WS_W_GATE1 = 31 * MiB,
                 WS_W_PROJ0 = 33 * MiB, WS_W_PROJ1 = 33 * MiB + 512 * 1024;
constexpr size_t WS_R1 = 34 * MiB, WS_R2 = 98 * MiB, WS_R3 = 162 * MiB, WS_R4 = 226 * MiB, WS_R5 = 290 * MiB, WS_R6 = 370 * MiB, WS_R7 = 402 * MiB, WS_R8 = 466 * MiB, WS_END = 498 * MiB;
constexpr size_t WS_PP1 = WS_R1, WS_PP0 = WS_R2, WS_K = WS_R2, WS_XB = WS_R1, WS_YB = WS_R3, WS_X1B = WS_R3, WS_Q = WS_R3, WS_OG = WS_R3, WS_X3B = WS_R5,
                 WS_SZ0 = WS_R4, WS_X2B = WS_R4, WS_AEXT = WS_R5, WS_GB = WS_R5, WS_V = WS_R5, WS_PB = WS_R8, WS_S = WS_R2,
                 WS_W1S = WS_R7, WS_BTS = WS_R7 + 8 * MiB, WS_SZ1 = WS_R7;

__device__ __forceinline__ float sum_fq(float s) {
    auto a = __builtin_amdgcn_permlane32_swap(__builtin_bit_cast(unsigned, s), __builtin_bit_cast(unsigned, s), false, false);
    s = __builtin_bit_cast(float, (unsigned)a[0]) + __builtin_bit_cast(float, (unsigned)a[1]);
    auto b = __builtin_amdgcn_permlane16_swap(__builtin_bit_cast(unsigned, s), __builtin_bit_cast(unsigned, s), false, false);
    return __builtin_bit_cast(float, (unsigned)b[0]) + __builtin_bit_cast(float, (unsigned)b[1]);
}
__device__ __forceinline__ size_t ln_off(int row, int col) {
    const int tile = (row >> 8) * 4 + (col >> 8), rl = row & 255, cl = col & 255;
    const int wid = ((rl >> 6) & 1) * 4 + ((cl >> 5) & 3), piece = (rl >> 7) * 8 + ((rl >> 4) & 3) * 2 + (cl >> 7), ln = ((cl >> 3) & 3) * 16 + (rl & 15);
    return (((size_t)tile * 8 + wid) * 16 + piece) * 512 + (size_t)ln * 8 + (cl & 7);
}
__device__ __forceinline__ unsigned cvtpk(float lo, float hi) { f32x2 v = {lo, hi}; bf16x2_t b = __builtin_convertvector(v, bf16x2_t); return __builtin_bit_cast(unsigned, b); }
__device__ __forceinline__ bf16_t f2bf(float f) { unsigned u = __builtin_bit_cast(unsigned, f); return (bf16_t)((u + 0x7fffu + ((u >> 16) & 1u)) >> 16); }
__device__ __forceinline__ float bf2f(unsigned short b) { return __builtin_bit_cast(float, (unsigned)b << 16); }
__device__ __forceinline__ float bflo(unsigned w) { return __builtin_bit_cast(float, w << 16); }
__device__ __forceinline__ float bfhi(unsigned w) { return __builtin_bit_cast(float, w & 0xffff0000u); }
__device__ __forceinline__ u32x4 pack8(f32x4 a, f32x4 b) { u32x4 w; w.x = cvtpk(a[0], a[1]); w.y = cvtpk(a[2], a[3]); w.z = cvtpk(b[0], b[1]); w.w = cvtpk(b[2], b[3]); return w; }
__device__ __forceinline__ void unpack8(u32x4 w, f32x4& a, f32x4& b) { a = (f32x4){bflo(w.x), bfhi(w.x), bflo(w.y), bfhi(w.y)}; b = (f32x4){bflo(w.z), bfhi(w.z), bflo(w.w), bfhi(w.w)}; }
__device__ __forceinline__ float sigmoidf_(float x) { return __builtin_amdgcn_rcpf(1.0f + __builtin_amdgcn_exp2f(-LOG2E * x)); }
__device__ __forceinline__ float siluf_(float x) { return x * sigmoidf_(x); }
__device__ __forceinline__ float gelu_tanh(float x) { const float t = x + 0.044715f * x * x * x; return x * __builtin_amdgcn_rcpf(1.0f + __builtin_amdgcn_exp2f(-2.302208198f * t)); }
__device__ __forceinline__ f32x4 sig4(f32x4 v) { return (f32x4){sigmoidf_(v[0]), sigmoidf_(v[1]), sigmoidf_(v[2]), sigmoidf_(v[3])}; }
__device__ __forceinline__ f32x4 silu4(f32x4 v) { return (f32x4){siluf_(v[0]), siluf_(v[1]), siluf_(v[2]), siluf_(v[3])}; }
__device__ __forceinline__ f32x4 gelu4(f32x4 v) { return (f32x4){gelu_tanh(v[0]), gelu_tanh(v[1]), gelu_tanh(v[2]), gelu_tanh(v[3])}; }
__device__ __forceinline__ float sumsq4(f32x4 v) { return (v[0] * v[0] + v[1] * v[1]) + (v[2] * v[2] + v[3] * v[3]); }
__device__ __forceinline__ float wave_sum(float v) {
    v += __builtin_bit_cast(float, __builtin_amdgcn_update_dpp(0, __builtin_bit_cast(int, v), 0xB1, 0xF, 0xF, true));
    v += __builtin_bit_cast(float, __builtin_amdgcn_update_dpp(0, __builtin_bit_cast(int, v), 0x4E, 0xF, 0xF, true));
    v += __builtin_bit_cast(float, __builtin_amdgcn_update_dpp(0, __builtin_bit_cast(int, v), 0x141, 0xF, 0xF, true));
    v += __builtin_bit_cast(float, __builtin_amdgcn_update_dpp(0, __builtin_bit_cast(int, v), 0x140, 0xF, 0xF, true));
    return sum_fq(v);
}

namespace pg8 {
constexpr int BM = 256, BK = 64, HALF = 128, HTB = HALF * BK * 2, STAGE_BYTES = 8 * HTB, NXCD = 8, WGM = 8;
__host__ __device__ __forceinline__ int lds_byte(int r, int c) { const int st = (r >> 4) * 2 + (c >> 5), rr = r & 15, cc = c & 31, ob = rr * 64 + cc * 2; return st * 1024 + (ob ^ (((ob >> 9) & 1) << 5)); }
__host__ __device__ __forceinline__ void stage_rc(int b, int& R, int& C) { const int st = b / 1024, sb = b % 1024, swz = sb ^ (((sb >> 9) & 1) << 5); R = (st >> 1) * 16 + swz / 64; C = (st & 1) * 32 + (swz % 64) / 2; }
__host__ __device__ __forceinline__ int perm32(int rho) { const int n = rho >> 4, i = rho & 15; return 8 * (i >> 2) + 4 * n + (i & 3); }

struct Unit { int pm, pn, nt; };
struct Gemm { const bf16_t* A; const bf16_t* Bt; int lda, ldb; };

struct StaticOrder {
    int nM, nN, nwg, G, c, nt;
    __device__ void init(int M_, int N_, int K_, int G_, int c_) { nM = M_ / BM; nN = N_ / BM; nwg = nM * nN; G = G_; c = c_; nt = K_ / BK; }
    __device__ bool next(int i, Unit& u) const {
        const long L = (long)i * G + c; if (L >= nwg) return false;
        int wgid = (int)L; { const int q = nwg / NXCD, r = nwg % NXCD, xcd = wgid % NXCD, off = wgid / NXCD; wgid = (xcd < r ? xcd * (q + 1) : r * (q + 1) + (xcd - r) * q) + off; }
        const int nig = WGM * nN, gid = wgid / nig, fm = gid * WGM, gsz = (nM - fm) < WGM ? (nM - fm) : WGM;
        u.pm = fm + ((wgid % nig) % gsz); u.pn = (wgid % nig) / gsz; u.nt = nt; return true;
    }
};
struct DualOrder {
    StaticOrder so; bool xl; int X, k, nrounds;
    __device__ void init(int M_, int N_, int K_, int G_, int c_, bool xl_, int X_, int k_) { so.init(M_, N_, K_, G_, c_); xl = xl_; X = X_; k = k_; nrounds = N_ / BM / 2; }
    __device__ bool next(int i, Unit& u) const {
        if (!xl) return so.next(i, u);
        if (i >= nrounds) return false;
        u.pm = 16 * X + (k & 7) + 8 * (i & 1); u.pn = (k >> 3) + 4 * (i >> 1); u.nt = so.nt; return true;
    }
};
struct SsmOrder {
    int G, v; bool xl; int XI, KR;
    __device__ bool next(int i, Unit& u) const {
        int g, b;
        if (xl) { if (i >= 2) return false; g = KR * 2 + i; b = XI; }
        else { const int L = i * G + v; if (L >= 512) return false; g = L >> 3; b = L & 7; }
        int nt = KX / BK; asm volatile("" : "+s"(nt));
        u.pm = g * 8 + b; u.pn = g; u.nt = nt; return true;
    }
};

template <class Epi, class Sched, bool ALIGN_EPI, int AMODE = 0>
__device__ __forceinline__ void gemm_phase(LAS unsigned char* lds, const Gemm g, const Sched& S, const Epi& E) {
    int tid = threadIdx.x; asm volatile("" : "+v"(tid));
    const int wid = __builtin_amdgcn_readfirstlane(tid >> 6), lane = tid & 63, wr = wid >> 2, wc = wid & 3, fr = lane & 15, fq = lane >> 4;
    unsigned voffA[2], voffB[2];
#pragma unroll
    for (int i = 0; i < 2; ++i) { int R, C; stage_rc(tid * 16 + i * 8192, R, C); const int Rb = Epi::PERM ? ((R & ~31) + perm32(R & 31)) : R;
        voffA[i] = AMODE == 1 ? (unsigned)(((C >> 4) * g.lda + R) * 16 + (C & 15)) * 2u
                 : (AMODE == 3 ? (unsigned)(((((R >> 6) & 1) * 4 + ((C >> 5) & 1)) * 16 + ((R >> 4) & 3) * 2) * 1024 + (tid & 63) * 16) : (unsigned)(R * g.lda + C) * 2u);
        voffB[i] = (unsigned)(Rb * g.ldb + C) * 2u; }
    const size_t kstep = (size_t)(BK * 2), kstepA = AMODE == 1 ? (size_t)(BK / 16) * g.lda * 32 : kstep;
    auto AK = [&](int kt) -> size_t { if constexpr (AMODE == 3) return (size_t)(kt >> 2) * 131072 + (size_t)(kt & 1) * 32768 + (size_t)((kt >> 1) & 1) * 1024; else return (size_t)kt * kstepA; };
    const size_t hstepA = AMODE == 1 ? (size_t)HALF * 32 : (AMODE == 3 ? (size_t)8192 : (size_t)HALF * g.lda * 2), hstepB = (size_t)HALF * g.ldb * 2;
    const size_t tstepA = AMODE == 3 ? (size_t)524288 : 2 * hstepA, tstepB = 2 * hstepB;
    const unsigned ldsw = (unsigned)wid * 1024u;
    const int aoff = AMODE == 3 ? wr * 8192 + lane * 16 : lds_byte(wr * 64 + fr, fq * 8), boff = lds_byte(wc * 32 + fr, fq * 8);
#define PG8_SA(b, h) (((b) * 2 + (h)) * HTB)
#define PG8_SB(b, h) ((4 + (b) * 2 + (h)) * HTB)
#define PG8_STAGE(bufoff, gbase, voff) do { _Pragma("unroll") for (int _i = 0; _i < 2; ++_i) \
        __builtin_amdgcn_global_load_lds((const unsigned*)((const char*)(gbase) + (voff)[_i]), (LAS unsigned*)(lds + (bufoff) + ldsw + _i * 8192), 16, 0, 0); } while (0)
#define PG8_LDA(dst, b, h) do { _Pragma("unroll") for (int m = 0; m < 4; ++m) _Pragma("unroll") for (int k = 0; k < 2; ++k) dst[m][k] = *(const LAS bf16x8*)(lds + PG8_SA(b, h) + aoff + m * 2048 + k * 1024); } while (0)
#define PG8_LDB(dst, b, h) do { _Pragma("unroll") for (int n = 0; n < 2; ++n) _Pragma("unroll") for (int k = 0; k < 2; ++k) dst[n][k] = *(const LAS bf16x8*)(lds + PG8_SB(b, h) + boff + n * 2048 + k * 1024); } while (0)
#define PG8_MMA(ai, bj, At, Bt) do { __builtin_amdgcn_s_setprio(1); _Pragma("unroll") for (int m = 0; m < 4; ++m) _Pragma("unroll") for (int n = 0; n < 2; ++n) _Pragma("unroll") for (int k = 0; k < 2; ++k) \
        acc[ai][bj][m][n] = __builtin_amdgcn_mfma_f32_16x16x32_bf16(Bt[n][k], At[m][k], acc[ai][bj][m][n], 0, 0, 0); __builtin_amdgcn_s_setprio(0); } while (0)
#define PG8_WAIT_V(n) asm volatile("s_waitcnt vmcnt(" #n ")" ::: "memory")
#define PG8_WAIT_L(n) asm volatile("s_waitcnt lgkmcnt(" #n ")" ::: "memory")
#define PG8_BAR __builtin_amdgcn_s_barrier()
#define PG8_SCHED __builtin_amdgcn_sched_barrier(0)
    Unit cur, nxt; int ui = 0;
    if (!S.next(0, cur)) return;
    f32x4 acc[2][2][4][2];
#pragma unroll
    for (int a = 0; a < 2; ++a)
#pragma unroll
        for (int b = 0; b < 2; ++b)
#pragma unroll
            for (int m = 0; m < 4; ++m)
#pragma unroll
                for (int n = 0; n < 2; ++n) acc[a][b][m][n] = (f32x4){0.f, 0.f, 0.f, 0.f};
    bf16x8 At[4][2], B0[2][2], B1[2][2];
    const char* cA = (const char*)g.A + (size_t)cur.pm * tstepA; const char* cB = (const char*)g.Bt + (size_t)cur.pn * tstepB;
    PG8_STAGE(PG8_SB(0, 0), cB, voffB); PG8_STAGE(PG8_SB(0, 1), cB + hstepB, voffB); PG8_STAGE(PG8_SA(0, 0), cA, voffA); PG8_STAGE(PG8_SA(0, 1), cA + hstepA, voffA);
    if (wr == 1) PG8_BAR;
    PG8_WAIT_V(2); PG8_BAR;
    PG8_STAGE(PG8_SB(1, 0), cB + kstep, voffB); PG8_STAGE(PG8_SA(1, 0), cA + AK(1), voffA); PG8_STAGE(PG8_SB(1, 1), cB + hstepB + kstep, voffB);
    PG8_WAIT_V(6); PG8_BAR;
    for (;;) {
        const bool has_next = S.next(ui + 1, nxt);
        const char* nA = has_next ? (const char*)g.A + (size_t)nxt.pm * tstepA : cA; const char* nB = has_next ? (const char*)g.Bt + (size_t)nxt.pn * tstepB : cB;
        const int nt = cur.nt;
        for (int t = 0; t < nt; t += 2) {
            const bool last = (t == nt - 2);
            const char* a1 = cA + AK(t + 1);
            const char* a2 = last ? nA : cA + AK(t + 2); const char* b2 = last ? nB : cB + (size_t)(t + 2) * kstep;
            const char* a3 = last ? nA + AK(1) : cA + AK(t + 3); const char* b3 = b2 + kstep;
            PG8_LDB(B0, 0, 0); PG8_LDB(B1, 0, 1); PG8_SCHED; PG8_LDA(At, 0, 0); PG8_STAGE(PG8_SA(1, 1), a1 + hstepA, voffA);
            PG8_WAIT_V(8); PG8_WAIT_L(0); PG8_BAR; PG8_MMA(0, 0, At, B0); PG8_MMA(0, 1, At, B1); PG8_BAR; PG8_SCHED;
            PG8_LDA(At, 0, 1); PG8_STAGE(PG8_SB(0, 0), b2, voffB); PG8_STAGE(PG8_SB(0, 1), b2 + hstepB, voffB); PG8_STAGE(PG8_SA(0, 0), a2, voffA);
            PG8_WAIT_V(8); PG8_WAIT_L(0); PG8_BAR; PG8_MMA(1, 0, At, B0); PG8_MMA(1, 1, At, B1); PG8_BAR; PG8_SCHED;
            PG8_LDB(B0, 1, 0); PG8_LDB(B1, 1, 1); PG8_SCHED; PG8_LDA(At, 1, 0); PG8_STAGE(PG8_SA(0, 1), a2 + hstepA, voffA);
            PG8_WAIT_V(8); PG8_WAIT_L(0); PG8_BAR; PG8_MMA(0, 0, At, B0); PG8_MMA(0, 1, At, B1); PG8_BAR; PG8_SCHED;
            PG8_LDA(At, 1, 1); PG8_STAGE(PG8_SB(1, 0), b3, voffB); PG8_STAGE(PG8_SB(1, 1), b3 + hstepB, voffB); PG8_STAGE(PG8_SA(1, 0), a3, voffA);
            PG8_WAIT_V(8); PG8_WAIT_L(0); PG8_BAR; PG8_MMA(1, 0, At, B0); PG8_MMA(1, 1, At, B1); PG8_BAR; PG8_SCHED;
        }
        if constexpr (ALIGN_EPI) { if (wr == 0) PG8_BAR; }
        { int pm_ = cur.pm, pn_ = cur.pn; asm volatile("" : "+s"(pm_), "+s"(pn_)); cur.pm = pm_; cur.pn = pn_; }
        E(acc, cur, wr, wc, fr, fq);
        if (!has_next) break;
#pragma unroll
        for (int a = 0; a < 2; ++a)
#pragma unroll
            for (int b = 0; b < 2; ++b)
#pragma unroll
                for (int m = 0; m < 4; ++m)
#pragma unroll
                    for (int n = 0; n < 2; ++n) acc[a][b][m][n] = (f32x4){0.f, 0.f, 0.f, 0.f};
        cur = nxt; cA = nA; cB = nB; ++ui;
        if constexpr (ALIGN_EPI) { if (wr == 1) PG8_BAR; }
    }
    PG8_WAIT_V(0);
    if constexpr (!ALIGN_EPI) { if (wr == 0) PG8_BAR; }
    PG8_BAR;
#undef PG8_SA
#undef PG8_SB
#undef PG8_STAGE
#undef PG8_LDA
#undef PG8_LDB
#undef PG8_MMA
#undef PG8_WAIT_V
#undef PG8_WAIT_L
#undef PG8_BAR
#undef PG8_SCHED
}

#define EPI_ROW(u, ai, m) ((u).pm * BM + (ai) * HALF + wr * 64 + (m) * 16 + fr)
typedef const f32x4 (&AccRef)[2][2][4][2];
#define LN_OFF(tile, ai, m, bj) ((((size_t)(tile) * 8 + (wr * 4 + wc)) * 2 + (ai)) * 4096 + (size_t)(fq * 16 + fr) * 8 + 2048 + (((m) * 2 + (bj)) * 512 - 2048))

__device__ __forceinline__ void row_scales(const float* ssp, const Unit& u, int wr, int fr, int fq, float (&r)[2][4]) {
    f32x4 p[2][4];
#pragma unroll
    for (int ai = 0; ai < 2; ++ai)
#pragma unroll
        for (int m = 0; m < 4; ++m) p[ai][m] = *(const f32x4*)(ssp + (size_t)EPI_ROW(u, ai, m) * 16 + 4 * fq);
#pragma unroll
    for (int ai = 0; ai < 2; ++ai)
#pragma unroll
        for (int m = 0; m < 4; ++m) { float s = (p[ai][m][0] + p[ai][m][1]) + (p[ai][m][2] + p[ai][m][3]); s += __shfl_xor(s, 16); s += __shfl_xor(s, 32); r[ai][m] = rsqrtf(s * (1.0f / DM) + EPS); }
}
constexpr int LDS_RS_OFF = 131072;
__device__ __forceinline__ void row_scales_to_lds(const float* ssp, int pm0, LAS float* rlds) {
    const int tid = threadIdx.x, slot = tid >> 8, rowl = tid & 255;
    const f32x4* sp = (const f32x4*)(ssp + ((size_t)(pm0 + 8 * slot) * BM + rowl) * 16);
    const f32x4 s4 = (sp[0] + sp[1]) + (sp[2] + sp[3]);
    rlds[tid] = rsqrtf(((s4[0] + s4[1]) + (s4[2] + s4[3])) * (1.0f / DM) + EPS);
    __syncthreads();
}
__device__ __forceinline__ void row_scales1_to_lds(const float* ss, int pm0, LAS float* rlds) {
    const int tid = threadIdx.x, slot = tid >> 8, rowl = tid & 255;
    rlds[tid] = rsqrtf(ss[(size_t)(pm0 + 8 * slot) * BM + rowl] * (1.0f / DM) + EPS);
    __syncthreads();
}
__device__ __forceinline__ void row_scales_from_lds(const LAS float* rlds, const Unit& u, int wr, int fr, float (&r)[2][4]) {
    const LAS float* p = rlds + ((u.pm >> 3) & 1) * 256 + wr * 64 + fr;
#pragma unroll
    for (int ai = 0; ai < 2; ++ai)
#pragma unroll
        for (int m = 0; m < 4; ++m) r[ai][m] = p[ai * HALF + m * 16];
}
struct EpiInProj {
    static constexpr bool PERM = true;
    const float* ss0; bf16_t* aext; bf16_t* sz; const LAS float* rlds;
    __device__ __forceinline__ void operator()(AccRef acc, const Unit& u, int wr, int wc, int fr, int fq) const {
        float sr[2][4];
        if (rlds) row_scales_from_lds(rlds, u, wr, fr, sr);
        else {
#pragma unroll
            for (int ai = 0; ai < 2; ++ai)
#pragma unroll
                for (int m = 0; m < 4; ++m) sr[ai][m] = ss0[EPI_ROW(u, ai, m)];
#pragma unroll
            for (int ai = 0; ai < 2; ++ai)
#pragma unroll
                for (int m = 0; m < 4; ++m) sr[ai][m] = rsqrtf(sr[ai][m] * (1.0f / DM) + EPS);
        }
#pragma unroll
        for (int ai = 0; ai < 2; ++ai)
#pragma unroll
            for (int m = 0; m < 4; ++m) {
                const int row = EPI_ROW(u, ai, m); const float r = sr[ai][m];
#pragma unroll
                for (int bj = 0; bj < 2; ++bj) {
                    const int col8 = u.pn * BM + bj * HALF + wc * 32 + 8 * fq;
                    f32x4 v0 = acc[ai][bj][m][0] * r, v1 = acc[ai][bj][m][1] * r;
                    if (u.pn < 4) { const int g = col8 >> 4, cc = col8 & 15, chunk = row / TC, s = row % TC;
                        *(u32x4*)(aext + ((size_t)(g * NCHUNK + chunk) * KX + 128 + s * 16 + cc)) = pack8(v0, v1); }
                    else *(u32x4*)(sz + LN_OFF(u.pm * 4 + (u.pn - 4), ai, m, bj)) = pack8(silu4(v0), silu4(v1));
                }
            }
    }
};
struct EpiStore {
    static constexpr bool PERM = true;
    bf16_t* o;
    __device__ __forceinline__ void operator()(AccRef acc, const Unit& u, int wr, int wc, int fr, int fq) const {
#pragma unroll
        for (int ai = 0; ai < 2; ++ai)
#pragma unroll
            for (int m = 0; m < 4; ++m) {
#pragma unroll
                for (int bj = 0; bj < 2; ++bj) *(u32x4*)(o + LN_OFF(u.pm * 4 + u.pn, ai, m, bj)) = pack8(acc[ai][bj][m][0], acc[ai][bj][m][1]); }
    }
};
struct EpiY {
    static constexpr bool PERM = true;
    bf16_t* yb;
    __device__ __forceinline__ void operator()(AccRef acc, const Unit& u, int wr, int wc, int fr, int fq) const {
        const int g = u.pm >> 3, ir = u.pm & 7;
#pragma unroll
        for (int ai = 0; ai < 2; ++ai)
#pragma unroll
            for (int m = 0; m < 4; ++m) { const int chunk = ir * 256 + ai * HALF + wr * 64 + m * 16 + fr;
#pragma unroll
                for (int bj = 0; bj < 2; ++bj) { const int idx = bj * HALF + wc * 32 + 8 * fq, t = idx >> 4, c = idx & 15;
                    *(u32x4*)(yb + ((size_t)g * M + chunk * TC + t) * GC + c) = pack8(gelu4(acc[ai][bj][m][0]), gelu4(acc[ai][bj][m][1])); } }
    }
};
struct EpiGlu {
    static constexpr bool PERM = true;
    const bf16_t* sz; bf16_t* gb;
    __device__ __forceinline__ void operator()(AccRef acc, const Unit& u, int wr, int wc, int fr, int fq) const {
        u32x4 zq[2][4];
#pragma unroll
        for (int ai = 0; ai < 2; ++ai)
#pragma unroll
            for (int m = 0; m < 4; ++m) zq[ai][m] = __builtin_nontemporal_load((const u32x4*)(sz + LN_OFF(u.pm * 4 + (u.pn >> 1), ai, m, u.pn & 1)));
#pragma unroll
        for (int ai = 0; ai < 2; ++ai)
#pragma unroll
            for (int m = 0; m < 4; ++m) { const size_t off = LN_OFF(u.pm * 4 + (u.pn >> 1), ai, m, u.pn & 1);
                f32x4 z0, z1; unpack8(zq[ai][m], z0, z1);
                const f32x4 o0 = acc[ai][0][m][0] * sig4(acc[ai][1][m][0]) * z0, o1 = acc[ai][0][m][1] * sig4(acc[ai][1][m][1]) * z1;
                *(u32x4*)(gb + off) = pack8(o0, o1); }
    }
};
template <bool BASE_BF16, bool BASE_LN = true> struct EpiOutRes {
    static constexpr bool PERM = true;
    static constexpr int NG = BASE_BF16 ? 8 : 4;
    const float* basef; const bf16_t* baseb; bf16_t* xb; float* ssp;
    __device__ __forceinline__ void operator()(AccRef acc, const Unit& u, int wr, int wc, int fr, int fq) const {
#pragma unroll
        for (int g0 = 0; g0 < 8; g0 += NG) {
            f32x4 bf_[BASE_BF16 ? 1 : NG][2][2]; u32x4 bb_[BASE_BF16 ? NG : 1][2];
#pragma unroll
            for (int gg = 0; gg < NG; ++gg)
#pragma unroll
                for (int bj = 0; bj < 2; ++bj) { const int ai = (g0 + gg) >> 2, m = (g0 + gg) & 3; const size_t off = BASE_LN ? LN_OFF(u.pm * 4 + u.pn, ai, m, bj) : (size_t)EPI_ROW(u, ai, m) * DM + u.pn * BM + bj * HALF + wc * 32 + 8 * fq;
                    if constexpr (BASE_BF16) bb_[gg][bj] = __builtin_nontemporal_load((const u32x4*)(baseb + off)); else { bf_[gg][bj][0] = *(const f32x4*)(basef + off); bf_[gg][bj][1] = *(const f32x4*)(basef + off + 4); } }
#pragma unroll
            for (int gg = 0; gg < NG; ++gg) { const int ai = (g0 + gg) >> 2, m = (g0 + gg) & 3; const int row = EPI_ROW(u, ai, m); float q = 0.f;
#pragma unroll
                for (int bj = 0; bj < 2; ++bj) { const size_t off = LN_OFF(u.pm * 4 + u.pn, ai, m, bj);
                    f32x4 b0, b1;
                    if constexpr (BASE_BF16) unpack8(bb_[gg][bj], b0, b1); else { b0 = bf_[gg][bj][0]; b1 = bf_[gg][bj][1]; }
                    const f32x4 v0 = acc[ai][bj][m][0] + b0, v1 = acc[ai][bj][m][1] + b1;
                    *(u32x4*)(xb + off) = pack8(v0, v1); q += sumsq4(v0) + sumsq4(v1); }
                q = sum_fq(q);
                if (fq == 0) ssp[(size_t)row * 16 + u.pn * 4 + wc] = q; }
        }
    }
};
template <bool FINAL> struct EpiGate {
    static constexpr bool PERM = true;
    static constexpr int NB = 2;
    const bf16_t* xin; const bf16_t* pp; const float* ssp_in; bf16_t* xb; float* ssp_out; float* outf; const LAS float* rlds;
    __device__ __forceinline__ void operator()(AccRef acc, const Unit& u, int wr, int wc, int fr, int fq) const {
        float rs[2][4]; if (rlds) row_scales_from_lds(rlds, u, wr, fr, rs); else row_scales(ssp_in, u, wr, fr, fq, rs);
#pragma unroll
        for (int ai = 0; ai < 2; ++ai)
#pragma unroll
            for (int m0 = 0; m0 < 4; m0 += NB) {
                const bf16_t* ppa = pp + LN_OFF(u.pm * 4 + u.pn, ai, 0, 0) + 2048; asm volatile("" : "+v"(ppa));
                const bf16_t* xa = xin + LN_OFF(u.pm * 4 + u.pn, ai, 0, 0) + 2048; asm volatile("" : "+v"(xa));
                u32x4 pq[NB][2], xq[NB][2];
#pragma unroll
                for (int mm = 0; mm < NB; ++mm)
#pragma unroll
                    for (int bj = 0; bj < 2; ++bj) { pq[mm][bj] = __builtin_nontemporal_load((const u32x4*)(ppa + (((m0 + mm) * 2 + bj) * 512 - 2048))); xq[mm][bj] = *(const u32x4*)(xa + (((m0 + mm) * 2 + bj) * 512 - 2048)); }
#pragma unroll
                for (int mm = 0; mm < NB; ++mm) { const int m = m0 + mm; const int row = EPI_ROW(u, ai, m); const float r = rs[ai][m]; float q = 0.f;
#pragma unroll
                    for (int bj = 0; bj < 2; ++bj) { const size_t off = FINAL ? (size_t)row * DM + u.pn * BM + bj * HALF + wc * 32 + 8 * fq : LN_OFF(u.pm * 4 + u.pn, ai, m, bj);
                        f32x4 p0, p1, x0, x1; unpack8(pq[mm][bj], p0, p1); unpack8(xq[mm][bj], x0, x1);
                        const f32x4 v0 = x0 + sig4(acc[ai][bj][m][0] * r) * p0, v1 = x1 + sig4(acc[ai][bj][m][1] * r) * p1;
                        if (FINAL) { *(f32x4*)(outf + off) = v0; *(f32x4*)(outf + off + 4) = v1; }
                        else { *(u32x4*)(xb + off) = pack8(v0, v1); q += sumsq4(v0) + sumsq4(v1); } }
                    if (!FINAL) { q = sum_fq(q); if (fq == 0) ssp_out[(size_t)row * 16 + u.pn * 4 + wc] = q; } }
            }
    }
};
struct EpiQKV {
    static constexpr bool PERM = true;
    const float* ssp_in; const float* gk; const float* gq; bf16_t* kb; bf16_t* vb; bf16_t* qb; bf16_t* szb; float qscale; const LAS float* rlds;
    __device__ __forceinline__ void operator()(AccRef acc, const Unit& u, int wr, int wc, int fr, int fq) const {
        const int type = u.pn >> 2, colb = 256 * (u.pn & 3) + 64 * wc + 8 * fq;
        bf16_t* const dst = type == 0 ? kb : (type == 1 ? vb : (type == 2 ? qb : szb));
        const float* const gn = type == 0 ? gk : gq;
        f32x4 gv[2][2];
#pragma unroll
        for (int bj = 0; bj < 2; ++bj) { gv[bj][0] = *(const f32x4*)(gn + 32 * bj + 8 * fq); gv[bj][1] = *(const f32x4*)(gn + 32 * bj + 8 * fq + 4); }
        float rs[2][4]; if (rlds) row_scales_from_lds(rlds, u, wr, fr, rs); else row_scales(ssp_in, u, wr, fr, fq, rs);
#pragma unroll
        for (int ai = 0; ai < 2; ++ai)
#pragma unroll
            for (int m = 0; m < 4; ++m) { const int row = EPI_ROW(u, ai, m);
                const float r = rs[ai][m];
                f32x4 t[2][2];
                if (type == 0 || type == 2) {
                    float q = (sumsq4(acc[ai][0][m][0]) + sumsq4(acc[ai][0][m][1])) + (sumsq4(acc[ai][1][m][0]) + sumsq4(acc[ai][1][m][1]));
                    q = sum_fq(q);
                    const float sc = r * rsqrtf(r * r * q * (1.0f / 64.0f) + EPS) * (type == 2 ? qscale : 1.0f);
#pragma unroll
                    for (int bj = 0; bj < 2; ++bj) { t[bj][0] = acc[ai][bj][m][0] * sc * gv[bj][0]; t[bj][1] = acc[ai][bj][m][1] * sc * gv[bj][1]; }
                } else {
#pragma unroll
                    for (int bj = 0; bj < 2; ++bj) { t[bj][0] = acc[ai][bj][m][0] * r; t[bj][1] = acc[ai][bj][m][1] * r; }
                    if (type == 3) {
#pragma unroll
                        for (int bj = 0; bj < 2; ++bj) { t[bj][0] = silu4(t[bj][0]); t[bj][1] = silu4(t[bj][1]); }
                    }
                }
                if (type >= 2) {
#pragma unroll
                    for (int bj = 0; bj < 2; ++bj) *(u32x4*)(dst + (size_t)row * DM + colb + 32 * bj) = pack8(t[bj][0], t[bj][1]);
                } else {
                    const int bb = row >> 12, s = row & (SEQ - 1);
#pragma unroll
                    for (int bj = 0; bj < 2; ++bj) { const int c = colb + 32 * bj, hh = c >> 7, d = c & 127;
                        const size_t tb = ((size_t)((bb * NH + hh) * 64 + (s >> 6))) * 8192;
                        const size_t off = type == 0 ? tb + (d >> 3) * 512 + (s & 63) * 8 : tb + (d >> 5) * 2048 + (s & 63) * 32 + (d & 31);
                        *(u32x4*)(dst + off) = pack8(t[bj][0], t[bj][1]); }
                }
            }
    }
};
}

namespace att {
constexpr int SLOT = 32768, KOFF = 0, VOFF = 16384, NSLOT = 3;
constexpr int LDS_RING = 0, LDS_BT = NSLOT * SLOT, LDS_WSF = LDS_BT + 1024, LDS_MISC = LDS_WSF + 8 * 64 * 4, LDS_TOTAL = LDS_MISC + 64;
constexpr int LDS_EX = 0;
__device__ __forceinline__ int crow(int r, int hi) { return (r & 3) + 8 * (r >> 2) + 4 * hi; }
__device__ __forceinline__ void glds16(const void* gsrc, unsigned lds_dst) { unsigned keep;
    asm volatile("s_mov_b32 %0, m0\n\ts_mov_b32 m0, %2\n\ts_nop 0\n\tglobal_load_lds_dwordx4 %1, off\n\ts_mov_b32 m0, %0" : "=&s"(keep) : "v"(gsrc), "s"(lds_dst) : "memory"); }
__device__ __forceinline__ int t5_bucket(int n) {
    if (n < 16) return n;
    return 16 + (n >= 19) + (n >= 21) + (n >= 24) + (n >= 27) + (n >= 31) + (n >= 35) + (n >= 40) + (n >= 46) + (n >= 52) + (n >= 59) + (n >= 67) + (n >= 77) + (n >= 87) + (n >= 99) + (n >= 113);
}
struct Params { const bf16_t* q; const bf16_t* k; const bf16_t* v; const bf16_t* sz; bf16_t* og; const float* rel_bias; const float* gq; const float* gk;
                const float* lq1; const float* lk1; const float* lq2; const float* lk2; const float* subln; };

__device__ __forceinline__ void attn_unit(const Params& P, int bh, int qb, LAS unsigned char* shm, float lam, float qkmax) {
    const int tid = threadIdx.x, lane = tid & 63, r32 = lane & 31, hi = lane >> 5; const int wid = __builtin_amdgcn_readfirstlane(tid >> 6);
    const int cmap = wid >> 2, wq = wid & 3;
    const int b = bh >> 3, h = bh & 7; const long rowbase = (long)b * SEQ; const int q0 = qb * 128;
    const unsigned lds0 = (unsigned)(uintptr_t)shm;
    LAS float* bt = (LAS float*)(shm + LDS_BT);
    LAS float* wsf = (LAS float*)(shm + LDS_WSF) + wid * 64;
    {
        float bmax = -1e30f;
        for (int i = 0; i < 32; ++i) bmax = fmaxf(bmax, P.rel_bias[i * NH + h]);
        const float Bh = qkmax + bmax;
        if (tid <= 128) { const int n = tid - 1; bt[tid] = (tid == 0) ? -INFINITY : (P.rel_bias[t5_bucket(n) * NH + h] - Bh) * LOG2E; }
    }
    const bf16_t* Kh = P.k + rowbase * DM + h * 128; const bf16_t* Vh = P.v + rowbase * DM + h * 128;
    const bf16_t* ksrc0 = Kh + (long)lane * DM + (2 * wid) * 8; const bf16_t* ksrc1 = ksrc0 + 8;
    const int pc0 = 2 * wid, pc1 = 2 * wid + 1;
    const bf16_t* vsrc0 = Vh + (long)(16 * (pc0 & 3) + (lane >> 2)) * DM + (pc0 >> 2) * 32 + (lane & 3) * 8;
    const bf16_t* vsrc1 = Vh + (long)(16 * (pc1 & 3) + (lane >> 2)) * DM + (pc1 >> 2) * 32 + (lane & 3) * 8;
    const unsigned kdst = lds0 + LDS_RING + KOFF + (2 * wid) * 1024, vdst = lds0 + LDS_RING + VOFF + (2 * wid) * 1024;
#define DMA_TILE(t, slot) do { const long _o = (long)(t) * 64 * DM; const unsigned _s = (unsigned)(slot) * SLOT; \
    glds16(ksrc0 + _o, (unsigned)__builtin_amdgcn_readfirstlane(kdst + _s)); glds16(ksrc1 + _o, (unsigned)__builtin_amdgcn_readfirstlane(kdst + _s + 1024)); \
    glds16(vsrc0 + _o, (unsigned)__builtin_amdgcn_readfirstlane(vdst + _s)); glds16(vsrc1 + _o, (unsigned)__builtin_amdgcn_readfirstlane(vdst + _s + 1024)); } while (0)
    const int NT = 2 * qb + 2;
    DMA_TILE(0, 0); DMA_TILE(1, 1);
    const bf16_t* Qw = P.q + (rowbase + q0 + wq * 32 + r32) * DM + h * 128 + cmap * 64 + hi * 8;
    bf16x8 qr[4];
#pragma unroll
    for (int d0 = 0; d0 < 4; ++d0) qr[d0] = *(const bf16x8*)(Qw + d0 * 16);
    f32x16 o[4];
#pragma unroll
    for (int e = 0; e < 4; ++e) o[e] = f32x16{};
    float l_reg = 0.f;
    const int qpos = q0 + wq * 32 + r32;
    const int tband = (q0 - 112) >> 6;
    asm volatile("s_waitcnt vmcnt(0)" ::: "memory");
    __syncthreads();
    const float cfar = bt[128];
    int slot = 0;
    for (int t = 0; t < NT; ++t) {
        if (t > 0) { if (t + 1 < NT) asm volatile("s_waitcnt vmcnt(4)" ::: "memory"); else asm volatile("s_waitcnt vmcnt(0)" ::: "memory");
                     asm volatile("s_waitcnt lgkmcnt(0)\n\ts_barrier" ::: "memory"); }
        if (t + 2 < NT) { int s2 = slot + 2; if (s2 >= NSLOT) s2 -= NSLOT; DMA_TILE(t + 2, s2); }
        LAS unsigned char* Ks = shm + LDS_RING + slot * SLOT + KOFF;
        const int vbase = (int)(lds0 + LDS_RING + slot * SLOT + VOFF) + ((lane >> 4) & 1) * 32 + (lane & 3) * 8 + (4 * hi + ((lane & 15) >> 2)) * 64;
        const bool band = (t >= tband);
        f32x16 p0, p1;
        { const float ci = band ? 0.f : cfar;
#pragma unroll
          for (int r = 0; r < 16; ++r) { p0[r] = ci; p1[r] = ci; } }
        LAS unsigned char* kb = Ks + (cmap * 8 + hi) * 1024 + r32 * 16;
#pragma unroll
        for (int d0 = 0; d0 < 4; ++d0) {
            const bf16x8 k0 = *(const LAS bf16x8*)(kb + d0 * 2048), k1 = *(const LAS bf16x8*)(kb + d0 * 2048 + 512);
            p0 = __builtin_amdgcn_mfma_f32_32x32x16_bf16(k0, qr[d0], p0, 0, 0, 0);
            p1 = __builtin_amdgcn_mfma_f32_32x32x16_bf16(k1, qr[d0], p1, 0, 0, 0);
        }
        if (band) {
            const int nb = qpos - 64 * t - 4 * hi;
#pragma unroll
            for (int r = 0; r < 16; ++r) { const int n0 = nb - ((r & 3) + 8 * (r >> 2)); int i0 = n0 + 1, i1 = n0 - 31;
                i0 = i0 < 0 ? 0 : (i0 > 128 ? 128 : i0); i1 = i1 < 0 ? 0 : (i1 > 128 ? 128 : i1);
                p0[r] += bt[i0]; p1[r] += bt[i1]; }
        }
        float sacc = 0.f;
#pragma unroll
        for (int r = 0; r < 16; ++r) { p0[r] = __builtin_amdgcn_exp2f(p0[r]); p1[r] = __builtin_amdgcn_exp2f(p1[r]); sacc += p0[r] + p1[r]; }
        l_reg += sacc;
        u32x4 pw[4];
        pw[0] = (u32x4){cvtpk(p0[0], p0[1]), cvtpk(p0[2], p0[3]), cvtpk(p0[4], p0[5]), cvtpk(p0[6], p0[7])};
        pw[1] = (u32x4){cvtpk(p0[8], p0[9]), cvtpk(p0[10], p0[11]), cvtpk(p0[12], p0[13]), cvtpk(p0[14], p0[15])};
        pw[2] = (u32x4){cvtpk(p1[0], p1[1]), cvtpk(p1[2], p1[3]), cvtpk(p1[4], p1[5]), cvtpk(p1[6], p1[7])};
        pw[3] = (u32x4){cvtpk(p1[8], p1[9]), cvtpk(p1[10], p1[11]), cvtpk(p1[12], p1[13]), cvtpk(p1[14], p1[15])};
#pragma unroll
        for (int eb = 0; eb < 4; ++eb) {
            s16x4 lo[4], hi4[4];
#pragma unroll
            for (int ks = 0; ks < 4; ++ks) {
                asm volatile("ds_read_b64_tr_b16 %0,%1 offset:%c2" : "=&v"(lo[ks]) : "v"(vbase), "i"(eb * 4096 + ks * 1024) : "memory");
                asm volatile("ds_read_b64_tr_b16 %0,%1 offset:%c2" : "=&v"(hi4[ks]) : "v"(vbase), "i"(eb * 4096 + ks * 1024 + 512) : "memory");
            }
            asm volatile("s_waitcnt lgkmcnt(0)" ::: "memory"); __builtin_amdgcn_sched_barrier(0);
#pragma unroll
            for (int ks = 0; ks < 4; ++ks) {
                const bf16x8 vf = (bf16x8){lo[ks][0], lo[ks][1], lo[ks][2], lo[ks][3], hi4[ks][0], hi4[ks][1], hi4[ks][2], hi4[ks][3]};
                o[eb] = __builtin_amdgcn_mfma_f32_32x32x16_bf16(__builtin_bit_cast(bf16x8, pw[ks]), vf, o[eb], 0, 0, 0);
            }
        }
        slot = (slot + 1 == NSLOT) ? 0 : slot + 1;
    }
#undef DMA_TILE
    { auto rr = __builtin_amdgcn_permlane32_swap(__float_as_uint(l_reg), __float_as_uint(l_reg), false, false); l_reg = __uint_as_float(rr[0]) + __uint_as_float(rr[1]); }
    if (hi == 0) wsf[r32] = l_reg;
    asm volatile("s_waitcnt lgkmcnt(0)" ::: "memory");
    float rl[16];
#pragma unroll
    for (int r = 0; r < 16; ++r) rl[r] = __builtin_amdgcn_rcpf(wsf[crow(r, hi)]) * (cmap ? lam : 1.0f);
    asm volatile("s_waitcnt lgkmcnt(0)\n\ts_barrier" ::: "memory");
    LAS float* ex = (LAS float*)(shm + LDS_EX) + wq * 4096;
    if (cmap == 1) {
#pragma unroll
        for (int eb = 0; eb < 4; ++eb)
#pragma unroll
            for (int r = 0; r < 16; ++r) ex[(eb * 16 + r) * 64 + lane] = o[eb][r] * rl[r];
    }
    __syncthreads();
    if (cmap == 0) {
        float ssq[16];
#pragma unroll
        for (int r = 0; r < 16; ++r) ssq[r] = 0.f;
#pragma unroll
        for (int eb = 0; eb < 4; ++eb)
#pragma unroll
            for (int r = 0; r < 16; ++r) { const float v = o[eb][r] * rl[r] - ex[(eb * 16 + r) * 64 + lane]; o[eb][r] = v; ssq[r] += v * v; }
#pragma unroll
        for (int r = 0; r < 16; ++r) { float s = ssq[r]; s += __shfl_xor(s, 1); s += __shfl_xor(s, 2); s += __shfl_xor(s, 4); s += __shfl_xor(s, 8); s += __shfl_xor(s, 16);
            ssq[r] = rsqrtf(s * (1.0f / 128.0f) + EPS) * (1.0f - LAM_INIT); }
#pragma unroll
        for (int eb = 0; eb < 4; ++eb) { const float gsub = P.subln[eb * 32 + r32];
#pragma unroll
            for (int r = 0; r < 16; ++r) { const size_t off = (size_t)(rowbase + q0 + wq * 32 + crow(r, hi)) * DM + h * 128 + eb * 32 + r32;
                P.og[off] = f2bf(o[eb][r] * ssq[r] * gsub * bf2f(P.sz[off])); } }
    }
    __syncthreads();
}

__device__ __forceinline__ void attn_phase(const Params& P, LAS unsigned char* shm, int vcu, int G) {
    LAS float* misc = (LAS float*)(shm + LDS_MISC);
    if (threadIdx.x < 64) {
        const int l = threadIdx.x;
        float s1 = wave_sum(P.lq1[l] * P.lk1[l]), s2 = wave_sum(P.lq2[l] * P.lk2[l]);
        float mq = fabsf(P.gq[l]), mk = fabsf(P.gk[l]);
#pragma unroll
        for (int o = 1; o < 64; o <<= 1) { mq = fmaxf(mq, __shfl_xor(mq, o)); mk = fmaxf(mk, __shfl_xor(mk, o)); }
        if (l == 0) { misc[0] = expf(s1) - expf(s2) + LAM_INIT; misc[1] = 8.0f * mq * mk; }
    }
    __syncthreads();
    const float lam = misc[0], qkmax = misc[1];
    for (int U = vcu; U < 2048; U += G) {
        const int vv = U & 255, i = U >> 8, bh = vv >> 2, j = vv & 3;
        const int qb = (i & 1) ? (8 * (i >> 1) + 7 - j) : (8 * (i >> 1) + j);
        attn_unit(P, bh, qb, shm, lam, qkmax);
    }
}
}

namespace att2 {
using att::crow; using att::glds16; using att::t5_bucket; using att::Params;
constexpr int SLOTB = 16384, NSLOT = 3;
constexpr int LDS_K = 0, LDS_V = NSLOT * SLOTB, LDS_EX = 65536, LDS_BT = 131072, BT_STRIDE = 132, LDS_WSF = LDS_BT + 8 * BT_STRIDE * 4 + 128, LDS_MISC = LDS_WSF + 8 * 64 * 4, LDS_EXT = LDS_MISC + 128, LDS_TOTAL = LDS_EXT + 384 * 4;
typedef LAS const unsigned char* lds_cptr;
typedef short v4i16_t __attribute__((ext_vector_type(4)));
#define SBAR() __builtin_amdgcn_sched_barrier(0)
#define WAIT_BAR(N) asm volatile("s_waitcnt vmcnt(" #N ") lgkmcnt(0)\n\ts_barrier" ::: "memory")
__device__ __forceinline__ float rowsum32(float s) {
    s += __builtin_bit_cast(float, __builtin_amdgcn_update_dpp(0, __builtin_bit_cast(int, s), 0xB1, 0xF, 0xF, true));
    s += __builtin_bit_cast(float, __builtin_amdgcn_update_dpp(0, __builtin_bit_cast(int, s), 0x4E, 0xF, 0xF, true));
    s += __builtin_bit_cast(float, __builtin_amdgcn_update_dpp(0, __builtin_bit_cast(int, s), 0x141, 0xF, 0xF, true));
    s += __builtin_bit_cast(float, __builtin_amdgcn_update_dpp(0, __builtin_bit_cast(int, s), 0x140, 0xF, 0xF, true));
    auto rr = __builtin_amdgcn_permlane16_swap(__float_as_uint(s), __float_as_uint(s), false, false);
    return __uint_as_float(rr[0]) + __uint_as_float(rr[1]);
}
__device__ __forceinline__ s16x4 vtr(lds_cptr p) { return __builtin_bit_cast(s16x4, __builtin_amdgcn_ds_read_tr16_b64_v4i16((LAS v4i16_t*)p)); }
__device__ __forceinline__ void kload2(bf16x8* kf, lds_cptr kp, int j) { kf[2 * j] = *(const LAS bf16x8*)(kp + j * 2048); kf[2 * j + 1] = *(const LAS bf16x8*)(kp + j * 2048 + 512); }

__device__ __forceinline__ void attn_unit(const Params& P, int bh, int qb, LAS unsigned char* shm, float lam, bool first, bool has_next, int nbh, int nqb, bf16x8 (&qr)[4]) {
    const int tid = threadIdx.x, lane = tid & 63, r32 = lane & 31, hi = lane >> 5; const int wid = __builtin_amdgcn_readfirstlane(tid >> 6);
    const int cmap = wid >> 2, wq = wid & 3;
    const int b = bh >> 3, h = bh & 7; const long rowbase = (long)b * SEQ; const int q0 = qb * 128;
    const unsigned lds0 = (unsigned)(uintptr_t)shm;
    LAS float* bt = (LAS float*)(shm + LDS_BT) + h * BT_STRIDE;
    LAS float* wsf = (LAS float*)(shm + LDS_WSF) + wid * 64;
    const bf16_t* ksrc0 = P.k + (size_t)bh * 64 * 8192 + (2 * wid) * 512 + lane * 8; const bf16_t* ksrc1 = ksrc0 + 512;
    const bf16_t* vsrc0 = P.v + (size_t)bh * 64 * 8192 + (2 * wid) * 512 + lane * 8; const bf16_t* vsrc1 = vsrc0 + 512;
    const unsigned kdst = lds0 + LDS_K + (2 * wid) * 1024, vdst = lds0 + LDS_V + (2 * wid) * 1024;
    const int NT = 2 * qb + 2;
#define TCL(t) ((t) < NT ? (t) : NT - 1)
#define DMA_K0(t, slot) glds16(ksrc0 + (long)TCL(t) * 8192, (unsigned)__builtin_amdgcn_readfirstlane(kdst + (slot)))
#define DMA_K1(t, slot) glds16(ksrc1 + (long)TCL(t) * 8192, (unsigned)__builtin_amdgcn_readfirstlane(kdst + (slot) + 1024))
#define DMA_V0(t, slot) glds16(vsrc0 + (long)TCL(t) * 8192, (unsigned)__builtin_amdgcn_readfirstlane(vdst + (slot)))
#define DMA_V1(t, slot) glds16(vsrc1 + (long)TCL(t) * 8192, (unsigned)__builtin_amdgcn_readfirstlane(vdst + (slot) + 1024))
#define DMA_K(t, slot) do { DMA_K0(t, slot); DMA_K1(t, slot); } while (0)
#define DMA_V(t, slot) do { DMA_V0(t, slot); DMA_V1(t, slot); } while (0)
    if (first) { DMA_K(0, 0); DMA_V(0, 0); DMA_K(1, SLOTB); DMA_K(2, 2 * SLOTB); }
    if (first) { const bf16_t* Qw = P.q + (rowbase + q0 + wq * 32 + r32) * DM + h * 128 + cmap * 64 + hi * 8;
#pragma unroll
        for (int d0 = 0; d0 < 4; ++d0) qr[d0] = *(const bf16x8*)(Qw + d0 * 16); }
    f32x16 o[4];
#pragma unroll
    for (int e = 0; e < 4; ++e) o[e] = f32x16{};
    float l_reg = 0.f;
    const int qpos = q0 + wq * 32 + r32;
    const int tband = (q0 - 112) >> 6;
    const lds_cptr shm3 = (lds_cptr)shm;
    const lds_cptr kp0 = shm3 + LDS_K + (cmap * 8 + hi) * 1024 + r32 * 16;
    const lds_cptr vp0 = shm3 + LDS_V + ((lane >> 4) & 1) * 32 + (lane & 3) * 8 + (4 * hi + ((lane & 15) >> 2)) * 64;
    bf16x8 kf[8];
    LAS float* ext = (LAS float*)(shm + LDS_EXT);
    if (tid < 384) { int i_ = tid - 126; i_ = i_ < 0 ? 0 : (i_ > 128 ? 128 : i_); ext[tid] = bt[i_]; }
    asm volatile("s_waitcnt vmcnt(0) lgkmcnt(0)\n\ts_barrier" ::: "memory");
#define BAND(C0, C1, t) do { if ((t) >= tband) { const int nb_ = qpos - 64 * (t) - 4 * hi; \
        _Pragma("unroll") for (int r = 0; r < 16; ++r) { const int c_ = (r & 3) + 8 * (r >> 2); int j0_ = nb_ + 127 - c_, j1_ = nb_ + 95 - c_; \
            asm volatile("" : "+v"(j0_), "+v"(j1_)); C0[r] += ext[j0_]; C1[r] += ext[j1_]; } } } while (0)
    f32x16 pA0, pA1, pB0, pB1;
    { kload2(kf, kp0, 0); kload2(kf, kp0, 1); kload2(kf, kp0, 2); kload2(kf, kp0, 3);
      pA0 = f32x16{}; pA1 = f32x16{};
#pragma unroll
      for (int d0 = 0; d0 < 4; ++d0) { pA0 = __builtin_amdgcn_mfma_f32_32x32x16_bf16(kf[2 * d0], qr[d0], pA0, 0, 0, 0); pA1 = __builtin_amdgcn_mfma_f32_32x32x16_bf16(kf[2 * d0 + 1], qr[d0], pA1, 0, 0, 0); }
      BAND(pA0, pA1, 0);
#pragma unroll
      for (int r = 0; r < 16; ++r) { pA0[r] = __builtin_amdgcn_exp2f(pA0[r]); pA1[r] = __builtin_amdgcn_exp2f(pA1[r]); } }
    WAIT_BAR(0);
    DMA_K(3, 0); DMA_V(1, SLOTB);
    int sl_prev = 0, sl_cur = SLOTB, sl_next = 2 * SLOTB;
#define ROT() do { sl_prev = sl_cur; sl_cur = sl_next; sl_next = (sl_next == (NSLOT - 1) * SLOTB) ? 0 : sl_next + SLOTB; } while (0)
    kload2(kf, kp0 + sl_cur, 0); kload2(kf, kp0 + sl_cur, 1); kload2(kf, kp0 + sl_cur, 2); kload2(kf, kp0 + sl_cur, 3);
    WAIT_BAR(4);
    s16x4 vlo[8], vhi[8]; u32x4 pw0, pw1, pw2, pw3;
#define PKW(Pv, B) cvtpk(Pv[B], Pv[B + 1])
#define PAF(k) __builtin_bit_cast(bf16x8, pw##k)
#define VFR(i) (bf16x8){vlo[i][0], vlo[i][1], vlo[i][2], vlo[i][3], vhi[i][0], vhi[i][1], vhi[i][2], vhi[i][3]}
#define PIN(x) asm volatile("" : "+v"(x))
#define VRD(f) do { vlo[(f) & 7] = vtr(vp_ + (((f) & 3) * 4096 + ((f) >> 2) * 1024)); vhi[(f) & 7] = vtr(vp_ + (((f) & 3) * 4096 + ((f) >> 2) * 1024 + 512)); } while (0)
#define GAPA(MF, A0, A1, A2, A3, W0, W1, PW) do { MF; sacc += A0; sacc += A1; sacc += A2; sacc += A3; PIN(sacc); W0; W1; PIN(PW); SBAR(); } while (0)
#define EX(v) __builtin_amdgcn_exp2f(v)
#define GAPB(MF, X, B) do { MF; X[B] = EX(X[B]); X[B + 1] = EX(X[B + 1]); PIN(X); SBAR(); } while (0)
#define PVM(i, k) o[(i) & 3] = __builtin_amdgcn_mfma_f32_32x32x16_bf16(PAF(k), VFR((i) & 7), o[(i) & 3], 0, 0, 0)
#define STEP(C0, C1, P0, P1, t) do { SBAR(); \
    const lds_cptr vp_ = vp0 + sl_prev; const f32x16 zz_ = f32x16{}; \
    VRD(0); SBAR(); float sacc = (P0[0] + P0[1]); \
    GAPA(C0 = __builtin_amdgcn_mfma_f32_32x32x16_bf16(kf[0], qr[0], zz_, 0, 0, 0), P0[2], P0[3], P0[4], P0[5],     pw0[0] = PKW(P0, 0), pw0[1] = PKW(P0, 2), pw0); \
    VRD(1); SBAR(); GAPA(C1 = __builtin_amdgcn_mfma_f32_32x32x16_bf16(kf[1], qr[0], zz_, 0, 0, 0), P0[6], P0[7], P0[8], P0[9],     pw0[2] = PKW(P0, 4), pw0[3] = PKW(P0, 6), pw0); \
    VRD(2); SBAR(); GAPA(C0 = __builtin_amdgcn_mfma_f32_32x32x16_bf16(kf[2], qr[1], C0, 0, 0, 0),   P0[10], P0[11], P0[12], P0[13], pw1[0] = PKW(P0, 8), pw1[1] = PKW(P0, 10), pw1); \
    VRD(3); SBAR(); GAPA(C1 = __builtin_amdgcn_mfma_f32_32x32x16_bf16(kf[3], qr[1], C1, 0, 0, 0),   P0[14], P0[15], P1[0], P1[1],   pw1[2] = PKW(P0, 12), pw1[3] = PKW(P0, 14), pw1); \
    VRD(4); SBAR(); GAPA(C0 = __builtin_amdgcn_mfma_f32_32x32x16_bf16(kf[4], qr[2], C0, 0, 0, 0),   P1[2], P1[3], P1[4], P1[5],     pw2[0] = PKW(P1, 0), pw2[1] = PKW(P1, 2), pw2); \
    VRD(5); SBAR(); GAPA(C1 = __builtin_amdgcn_mfma_f32_32x32x16_bf16(kf[5], qr[2], C1, 0, 0, 0),   P1[6], P1[7], P1[8], P1[9],     pw2[2] = PKW(P1, 4), pw2[3] = PKW(P1, 6), pw2); \
    VRD(6); SBAR(); GAPA(C0 = __builtin_amdgcn_mfma_f32_32x32x16_bf16(kf[6], qr[3], C0, 0, 0, 0),   P1[10], P1[11], P1[12], P1[13], pw3[0] = PKW(P1, 8), pw3[1] = PKW(P1, 10), pw3); \
    VRD(7); SBAR(); GAPA(C1 = __builtin_amdgcn_mfma_f32_32x32x16_bf16(kf[7], qr[3], C1, 0, 0, 0),   P1[14], P1[15], 0.f, 0.f,       pw3[2] = PKW(P1, 12), pw3[3] = PKW(P1, 14), pw3); \
    l_reg += sacc; \
    BAND(C0, C1, t); \
    SBAR(); \
    GAPB(PVM(0, 0), C0, 0);   VRD(8);  SBAR(); \
    GAPB(PVM(1, 0), C0, 2);   VRD(9);  SBAR(); \
    GAPB(PVM(2, 0), C0, 4);   VRD(10); SBAR(); \
    GAPB(PVM(3, 0), C0, 6);   VRD(11); SBAR(); \
    GAPB(PVM(4, 1), C0, 8);   VRD(12); SBAR(); \
    GAPB(PVM(5, 1), C0, 10);  VRD(13); SBAR(); \
    GAPB(PVM(6, 1), C0, 12);  VRD(14); SBAR(); \
    GAPB(PVM(7, 1), C0, 14);  VRD(15); SBAR(); \
    GAPB(PVM(8, 2), C1, 0);   kload2(kf, kp0 + sl_next, 0); SBAR(); \
    GAPB(PVM(9, 2), C1, 2);   kload2(kf, kp0 + sl_next, 1); SBAR(); \
    GAPB(PVM(10, 2), C1, 4);  kload2(kf, kp0 + sl_next, 2); SBAR(); \
    GAPB(PVM(11, 2), C1, 6);  kload2(kf, kp0 + sl_next, 3); SBAR(); \
    GAPB(PVM(12, 3), C1, 8);  DMA_V0((t) + 1, sl_next); SBAR(); \
    GAPB(PVM(13, 3), C1, 10); DMA_V1((t) + 1, sl_next); SBAR(); \
    GAPB(PVM(14, 3), C1, 12); DMA_K0((t) + 3, sl_cur); SBAR(); \
    GAPB(PVM(15, 3), C1, 14); DMA_K1((t) + 3, sl_cur); SBAR(); \
    } while (0)
    int t = 1;
    for (; t + 1 < NT; t += 2) {
        STEP(pB0, pB1, pA0, pA1, t);     WAIT_BAR(4); ROT();
        STEP(pA0, pA1, pB0, pB1, t + 1); WAIT_BAR(4); ROT();
    }
    STEP(pB0, pB1, pA0, pA1, NT - 1); WAIT_BAR(4); ROT();
    { float sacc = pB0[0] + pB0[1];
#pragma unroll
      for (int r = 2; r < 16; ++r) sacc += pB0[r];
#pragma unroll
      for (int r = 0; r < 16; ++r) sacc += pB1[r];
      l_reg += sacc;
      pw0 = (u32x4){PKW(pB0, 0), PKW(pB0, 2), PKW(pB0, 4), PKW(pB0, 6)}; pw1 = (u32x4){PKW(pB0, 8), PKW(pB0, 10), PKW(pB0, 12), PKW(pB0, 14)};
      pw2 = (u32x4){PKW(pB1, 0), PKW(pB1, 2), PKW(pB1, 4), PKW(pB1, 6)}; pw3 = (u32x4){PKW(pB1, 8), PKW(pB1, 10), PKW(pB1, 12), PKW(pB1, 14)};
      const lds_cptr vp_ = vp0 + sl_prev;
      VRD(0); VRD(1); VRD(2); VRD(3); VRD(4); VRD(5); VRD(6); VRD(7);
      PVM(0, 0); PVM(1, 0); PVM(2, 0); PVM(3, 0); PVM(4, 1); PVM(5, 1); PVM(6, 1); PVM(7, 1);
      VRD(8); VRD(9); VRD(10); VRD(11); VRD(12); VRD(13); VRD(14); VRD(15);
      PVM(8, 2); PVM(9, 2); PVM(10, 2); PVM(11, 2); PVM(12, 3); PVM(13, 3); PVM(14, 3); PVM(15, 3); }
#undef STEP
#undef GAPA
#undef GAPB
#undef PVM
#undef VRD
#undef VFR
#undef PAF
#undef PKW
#undef PIN
#undef EX
#undef BAND
#undef DMA_K
#undef DMA_V
#undef DMA_K0
#undef DMA_K1
#undef DMA_V0
#undef DMA_V1
#undef TCL
#undef ROT
    { auto rr = __builtin_amdgcn_permlane32_swap(__float_as_uint(l_reg), __float_as_uint(l_reg), false, false); l_reg = __uint_as_float(rr[0]) + __uint_as_float(rr[1]); }
    if (hi == 0) wsf[r32] = l_reg;
    asm volatile("s_waitcnt lgkmcnt(0)" ::: "memory");
    float rl[16];
#pragma unroll
    for (int r = 0; r < 16; ++r) rl[r] = __builtin_amdgcn_rcpf(wsf[crow(r, hi)]) * (cmap ? lam : 1.0f);
    WAIT_BAR(0);
    const size_t gbase = (size_t)(rowbase + q0 + wq * 32) * DM + h * 128 + cmap * 64;
    u32x4 zq[4];
#pragma unroll
    for (int i = 0; i < 4; ++i) { const int pc = lane + 64 * i; zq[i] = __builtin_nontemporal_load((const u32x4*)(P.sz + gbase + (size_t)(pc >> 3) * DM + (pc & 7) * 8)); }
    if (has_next) {
        const int nt1 = (2 * nqb + 2 > 2) ? 2 : 1;
        const bf16_t* nk = P.k + (size_t)nbh * 64 * 8192 + (2 * wid) * 512 + lane * 8; const bf16_t* nv = P.v + (size_t)nbh * 64 * 8192 + (2 * wid) * 512 + lane * 8;
        glds16(nk, (unsigned)__builtin_amdgcn_readfirstlane(kdst)); glds16(nk + 512, (unsigned)__builtin_amdgcn_readfirstlane(kdst + 1024));
        glds16(nv, (unsigned)__builtin_amdgcn_readfirstlane(vdst)); glds16(nv + 512, (unsigned)__builtin_amdgcn_readfirstlane(vdst + 1024));
        glds16(nk + 8192, (unsigned)__builtin_amdgcn_readfirstlane(kdst + SLOTB)); glds16(nk + 8192 + 512, (unsigned)__builtin_amdgcn_readfirstlane(kdst + SLOTB + 1024));
        glds16(nk + (long)nt1 * 8192, (unsigned)__builtin_amdgcn_readfirstlane(kdst + 2 * SLOTB)); glds16(nk + (long)nt1 * 8192 + 512, (unsigned)__builtin_amdgcn_readfirstlane(kdst + 2 * SLOTB + 1024));
        const bf16_t* Qn = P.q + ((long)(nbh >> 3) * SEQ + nqb * 128 + wq * 32 + r32) * DM + (nbh & 7) * 128 + cmap * 64 + hi * 8;
#pragma unroll
        for (int d0 = 0; d0 < 4; ++d0) qr[d0] = *(const bf16x8*)(Qn + d0 * 16);
    }
    LAS float* ex = (LAS float*)(shm + LDS_EX) + wq * 4096;
    {
        LAS float* exs = ex + cmap * 2048;
#pragma unroll
        for (int e2 = 0; e2 < 2; ++e2)
#pragma unroll
            for (int r = 0; r < 16; ++r) exs[(e2 * 16 + r) * 64 + lane] = (cmap ? o[e2][r] : o[2 + e2][r]) * rl[r];
    }
    asm volatile("s_waitcnt lgkmcnt(0)\n\ts_barrier" ::: "memory");
    float vk[2][16], ssq[16];
    {   const LAS float* exr = ex + (cmap ^ 1) * 2048;
#pragma unroll
        for (int r = 0; r < 16; ++r) ssq[r] = 0.f;
#pragma unroll
        for (int e2 = 0; e2 < 2; ++e2)
#pragma unroll
            for (int r = 0; r < 16; ++r) { const float mine = (cmap ? o[2 + e2][r] : o[e2][r]) * rl[r], oth = exr[(e2 * 16 + r) * 64 + lane];
                const float v = cmap ? oth - mine : mine - oth; vk[e2][r] = v; ssq[r] += v * v; }
    }
#pragma unroll
    for (int r = 0; r < 16; ++r) ssq[r] = rowsum32(ssq[r]);
    if (r32 == 0) {
#pragma unroll
        for (int r = 0; r < 16; ++r) wsf[hi * 16 + r] = ssq[r];
    }
    asm volatile("s_waitcnt lgkmcnt(0)\n\ts_barrier" ::: "memory");
    { const LAS float* wsp = (const LAS float*)(shm + LDS_WSF) + (wid ^ 4) * 64 + hi * 16;
#pragma unroll
      for (int r = 0; r < 16; ++r) ssq[r] = rsqrtf((ssq[r] + wsp[r]) * (1.0f / 128.0f) + EPS) * (1.0f - LAM_INIT); }
#pragma unroll
    for (int e2 = 0; e2 < 2; ++e2) { const float gsub = P.subln[cmap * 64 + e2 * 32 + r32];
#pragma unroll
        for (int r = 0; r < 16; ++r) ex[crow(r, hi) * 128 + cmap * 64 + e2 * 32 + r32] = vk[e2][r] * ssq[r] * gsub; }
    asm volatile("s_waitcnt lgkmcnt(0)" ::: "memory");
#pragma unroll
    for (int i = 0; i < 4; ++i) { const int pc = lane + 64 * i; const LAS f32x4* sp = (const LAS f32x4*)(ex + (pc >> 3) * 128 + cmap * 64 + (pc & 7) * 8);
        f32x4 z0, z1; unpack8(zq[i], z0, z1);
        *(u32x4*)(P.og + gbase + (size_t)(pc >> 3) * DM + (pc & 7) * 8) = pack8(sp[0] * z0, sp[1] * z1); }
}
#undef SBAR
#undef WAIT_BAR

__device__ __forceinline__ void unit_of(int U, int vcu, int G, int& bh, int& qb) {
    if (G == 256) {
        const int k = U >> 8, x = vcu >> 5, c = vcu & 31; bh = x * 8 + k;
        qb = (k & 1) ? 31 - ((c + 4 * (k - 1)) & 31) : ((c + 4 * k) & 31);
    } else { bh = U >> 5; qb = U & 31; }
}
__device__ __forceinline__ void attn_phase(const Params& P, LAS unsigned char* shm, int vcu, int G) {
    LAS float* misc = (LAS float*)(shm + LDS_MISC);
    if (threadIdx.x < 64) {
        const int l = threadIdx.x;
        const float s1 = wave_sum(P.lq1[l] * P.lk1[l]), s2 = wave_sum(P.lq2[l] * P.lk2[l]);
        if (l == 0) misc[0] = expf(s1) - expf(s2) + LAM_INIT;
    }
    for (int e = threadIdx.x; e < 8 * 129; e += 512) { const int hh = e / 129, i = e - hh * 129, n = i - 1;
        ((LAS float*)(shm + LDS_BT))[hh * BT_STRIDE + i] = (i == 0) ? -INFINITY : (P.rel_bias[t5_bucket(n) * NH + hh] - P.rel_bias[31 * NH + hh]) * LOG2E; }
    __syncthreads();
    const float lam = misc[0];
    bool first = true; bf16x8 qr[4];
#pragma unroll
    for (int d0 = 0; d0 < 4; ++d0) qr[d0] = bf16x8{};
    if (__builtin_amdgcn_readfirstlane((int)(threadIdx.x >> 6)) >= 4) __builtin_amdgcn_s_setprio(1);
    for (int U = vcu; U < 2048; U += G) {
        int bh, qb, nbh = 0, nqb = 0; unit_of(U, vcu, G, bh, qb);
        const bool has_next = (U + G < 2048); if (has_next) unit_of(U + G, vcu, G, nbh, nqb);
        attn_unit(P, bh, qb, shm, lam, first, has_next, nbh, nqb, qr); first = false;
    }
    __builtin_amdgcn_s_setprio(0);
}
}

struct Args { const float* in[30]; float* out; unsigned char* ws; int ph_lo, ph_hi; };

constexpr int LDS_BYTES = 147456;

__device__ __forceinline__ void transpose_item(const float* W, int ldsrc, int scol0, const float* gain, bf16_t* WT, int K, int nrow0, int k0, LAS float* scr, int lane) {
    float wv[32];
#pragma unroll
    for (int i = 0; i < 32; ++i) wv[i] = W[(size_t)(k0 + 2 * i + (lane >> 5)) * ldsrc + scol0 + (lane & 31)];
#pragma unroll
    for (int i = 0; i < 32; ++i) { const int kk = 2 * i + (lane >> 5); float v = wv[i]; if (gain) v *= gain[k0 + kk]; scr[kk * 33 + (lane & 31)] = v; }
    asm volatile("s_waitcnt lgkmcnt(0)" ::: "memory");
    const int c = lane & 7;
#pragma unroll
    for (int j = 0; j < 4; ++j) { const int n = (lane >> 3) + 8 * j; const LAS float* s = scr + (8 * c) * 33 + n;
        u32x4 o; o.x = cvtpk(s[0 * 33], s[1 * 33]); o.y = cvtpk(s[2 * 33], s[3 * 33]); o.z = cvtpk(s[4 * 33], s[5 * 33]); o.w = cvtpk(s[6 * 33], s[7 * 33]);
        *(u32x4*)(WT + (size_t)(nrow0 + n) * K + k0 + 8 * c) = o; }
    asm volatile("s_waitcnt lgkmcnt(0)" ::: "memory");
}
__device__ __forceinline__ void cpow(float lr, float li, float dt, float n, float& re, float& im) { const float mag = __expf(lr * dt * n), ang = li * dt * n; re = mag * __cosf(ang); im = mag * __sinf(ang); }
__device__ __forceinline__ void zoh_f(float lr, float li, float dt, float& fr_, float& fi_) {
    const float x = lr * dt, y = li * dt, ex = __expf(x), sh = __sinf(0.5f * y);
    const float nr = expm1f(x) * __cosf(y) - 2.0f * sh * sh, ni = ex * __sinf(y), den = lr * lr + li * li;
    fr_ = (nr * lr + ni * li) / den; fi_ = (ni * lr - nr * li) / den;
}

__device__ __forceinline__ void prologue(const Args& a, LAS unsigned char* lds, int vcu, int G) {
    const int tid = threadIdx.x, lane = tid & 63, wave = __builtin_amdgcn_readfirstlane(tid >> 6);
    const int gw = vcu * 8 + wave, NGW = G * 8;
    unsigned char* ws = a.ws;
    const float *lam_re = a.in[4], *lam_im = a.in[5], *log_dt = a.in[6], *b_re = a.in[7], *b_im = a.in[8], *c_re = a.in[9], *c_im = a.in[10], *dvec = a.in[11];
    bf16_t* bts = (bf16_t*)(ws + WS_BTS); bf16_t* w1s = (bf16_t*)(ws + WS_W1S);
    constexpr int N_D3 = NG * TC, N_D1 = NG * TC, N_D2 = NG * TC, N_D4 = NG * TC, N_D5 = 64, TG = TC * GC, N_X = M / 8;
    constexpr int T_IN0 = 16 * 64, T_GLU = 16 * 64, T_SQ = 16 * 32, T_PRJ = 4 * 32, T_QKV = 16 * 128;
    constexpr int N_T = T_IN0 + T_GLU + 4 * T_SQ + 2 * T_PRJ + T_QKV;
    constexpr int O_D1 = N_D3, O_D2 = O_D1 + N_D1, O_D4 = O_D2 + N_D2, O_D5 = O_D4 + N_D4, O_T = O_D5 + N_D5, O_X = O_T + N_T, N_ALL = O_X + N_X;
    LAS float* scr = (LAS float*)(lds + wave * 16384);
    static_assert(N_ALL == 229 * 64, "item blocks");
    for (int it0 = gw; it0 < N_ALL; it0 += NGW) {
        const int it = ((((it0 >> 6) * 89) % 229) << 6) | (it0 & 63);
        if (it < O_D1) {
            const int g = it / TC, tau = it % TC; const float dt = __expf(log_dt[g]);
            { f32x4 ld[16];
              const f32x4* s0 = (const f32x4*)(c_re + (size_t)g * GC * NP) + lane; const f32x4* s1 = (const f32x4*)(c_im + (size_t)g * GC * NP) + lane;
              const f32x4* s2 = (const f32x4*)(b_re + (size_t)g * NP * GC) + lane; const f32x4* s3 = (const f32x4*)(b_im + (size_t)g * NP * GC) + lane;
#pragma unroll
              for (int i = 0; i < 4; ++i) { ld[i] = s0[64 * i]; ld[4 + i] = s1[64 * i]; ld[8 + i] = s2[64 * i]; ld[12 + i] = s3[64 * i]; }
#pragma unroll
              for (int a = 0; a < 4; ++a)
#pragma unroll
                for (int i = 0; i < 4; ++i) *(LAS f32x4*)(scr + a * 1024 + (lane + 64 * i) * 4) = ld[4 * a + i]; }
            float Gr, Gi;
            { const int p = lane; const float lr = lam_re[g * NP + p], li = lam_im[g * NP + p];
              float f_r, f_i, ar, ai; zoh_f(lr, li, dt, f_r, f_i); cpow(lr, li, dt, (float)tau, ar, ai);
              Gr = ar * f_r - ai * f_i; Gi = ar * f_i + ai * f_r; }
            asm volatile("s_waitcnt lgkmcnt(0)" ::: "memory");
            const int c = lane >> 2, q4 = (lane & 3) * 4;
            f32x4 kt = (f32x4){0.f, 0.f, 0.f, 0.f};
#pragma unroll
            for (int p0 = 0; p0 < NP; p0 += 4) {
                const f32x4 cr4 = *(const LAS f32x4*)(scr + c * NP + p0), ci4 = *(const LAS f32x4*)(scr + 1024 + c * NP + p0);
#pragma unroll
                for (int pp = 0; pp < 4; ++pp) { const int p = p0 + pp;
                    const float gr = __builtin_bit_cast(float, __builtin_amdgcn_readlane(__builtin_bit_cast(int, Gr), p)), gi = __builtin_bit_cast(float, __builtin_amdgcn_readlane(__builtin_bit_cast(int, Gi), p));
                    const float er = cr4[pp] * gr - ci4[pp] * gi, ei = cr4[pp] * gi + ci4[pp] * gr;
                    const f32x4 br = *(const LAS f32x4*)(scr + 2048 + p * GC + q4), bi = *(const LAS f32x4*)(scr + 3072 + p * GC + q4);
                    kt += er * br - ei * bi; }
            }
            if (tau == 0) {
#pragma unroll
                for (int j = 0; j < 4; ++j) if (q4 + j == c) kt[j] += dvec[g * GC + c];
            }
            const u32x2 w = (u32x2){cvtpk(kt[0], kt[1]), cvtpk(kt[2], kt[3])};
            for (int s = 0; s + tau < TC; ++s) *(u32x2*)(bts + ((size_t)g * TG + (s + tau) * GC + c) * KX + 128 + s * GC + q4) = w;
            asm volatile("s_waitcnt lgkmcnt(0)" ::: "memory");
        } else if (it < O_D2) {
            const int r = it - O_D1, g = r / TC, s = r % TC, p = lane; const float dt = __expf(log_dt[g]);
            const float lr = lam_re[g * NP + p], li = lam_im[g * NP + p];
            float f_r, f_i, ar, ai; zoh_f(lr, li, dt, f_r, f_i); cpow(lr, li, dt, (float)(TC - 1 - s), ar, ai);
            const float gr = ar * f_r - ai * f_i, gi = ar * f_i + ai * f_r;
            const float* br = b_re + (size_t)(g * NP + p) * GC; const float* bi = b_im + (size_t)(g * NP + p) * GC;
            float vr[16], vi[16];
#pragma unroll
            for (int j = 0; j < 16; ++j) { vr[j] = gr * br[j] - gi * bi[j]; vi[j] = gr * bi[j] + gi * br[j]; }
            bf16_t* dr = w1s + ((size_t)g * 128 + p) * TG + s * GC; bf16_t* di = dr + (size_t)64 * TG;
            *(u32x4*)dr = (u32x4){cvtpk(vr[0], vr[1]), cvtpk(vr[2], vr[3]), cvtpk(vr[4], vr[5]), cvtpk(vr[6], vr[7])};
            *(u32x4*)(dr + 8) = (u32x4){cvtpk(vr[8], vr[9]), cvtpk(vr[10], vr[11]), cvtpk(vr[12], vr[13]), cvtpk(vr[14], vr[15])};
            *(u32x4*)di = (u32x4){cvtpk(vi[0], vi[1]), cvtpk(vi[2], vi[3]), cvtpk(vi[4], vi[5]), cvtpk(vi[6], vi[7])};
            *(u32x4*)(di + 8) = (u32x4){cvtpk(vi[8], vi[9]), cvtpk(vi[10], vi[11]), cvtpk(vi[12], vi[13]), cvtpk(vi[14], vi[15])};
        } else if (it < O_D4) {
            const int r = it - O_D2, g = r / TC, t = r % TC, p = lane; const float dt = __expf(log_dt[g]);
            const float lr = lam_re[g * NP + p], li = lam_im[g * NP + p];
            float ar, ai; cpow(lr, li, dt, (float)(t + 1), ar, ai);
            float crv[GC], civ[GC];
#pragma unroll
            for (int c = 0; c < GC; ++c) { crv[c] = c_re[(g * GC + c) * NP + p]; civ[c] = c_im[(g * GC + c) * NP + p]; }
#pragma unroll
            for (int c = 0; c < GC; ++c) { const float cr = crv[c], ci = civ[c];
                bf16_t* d = bts + ((size_t)g * TG + t * GC + c) * KX; d[p] = f2bf(cr * ar - ci * ai); d[64 + p] = f2bf(-(cr * ai + ci * ar)); }
        } else if (it < O_D5) {
            const int r = it - O_D4, g = r / TC, t = r % TC; const int npc = (TC - 1 - t) * 2;
            for (int idx = lane; idx < GC * npc; idx += 64) { const int c = idx / npc, pc = idx - c * npc;
                *(u32x4*)(bts + ((size_t)g * TG + t * GC + c) * KX + 128 + (t + 1) * GC + pc * 8) = (u32x4){0u, 0u, 0u, 0u}; }
        } else if (it < O_T) {
            const int g = it - O_D5, p = lane; float ar, ai; cpow(lam_re[g * NP + p], lam_im[g * NP + p], __expf(log_dt[g]), (float)TC, ar, ai);
            float* at = (float*)(ws + WS_AT); at[(g * NP + p) * 2] = ar; at[(g * NP + p) * 2 + 1] = ai;
        } else if (it < O_X) {
            int r = it - O_T;
            if (r < T_IN0) { const int kb = r >> 6, nb = r & 63; transpose_item(a.in[3], 2048, 32 * nb, a.in[2], (bf16_t*)(ws + WS_W_IN0), 1024, 32 * nb, 64 * kb, scr, lane); continue; } r -= T_IN0;
            if (r < T_GLU) { const int kb = r >> 6, nb = r & 63, n0 = 32 * nb; transpose_item(a.in[12], 2048, ((n0 >> 7) & 1) * 1024 + 128 * (n0 >> 8) + (n0 & 127), nullptr, (bf16_t*)(ws + WS_W_GLU), 1024, n0, 64 * kb, scr, lane); continue; } r -= T_GLU;
            if (r < T_SQ) { transpose_item(a.in[13], 1024, 32 * (r & 31), nullptr, (bf16_t*)(ws + WS_W_OUT0), 1024, 32 * (r & 31), 64 * (r >> 5), scr, lane); continue; } r -= T_SQ;
            if (r < T_SQ) { transpose_item(a.in[29], 1024, 32 * (r & 31), nullptr, (bf16_t*)(ws + WS_W_GATE0), 1024, 32 * (r & 31), 64 * (r >> 5), scr, lane); continue; } r -= T_SQ;
            if (r < T_SQ) { transpose_item(a.in[26], 1024, 32 * (r & 31), nullptr, (bf16_t*)(ws + WS_W_OUT1), 1024, 32 * (r & 31), 64 * (r >> 5), scr, lane); continue; } r -= T_SQ;
            if (r < T_SQ) { transpose_item(a.in[29] + (size_t)DM * DM, 1024, 32 * (r & 31), nullptr, (bf16_t*)(ws + WS_W_GATE1), 1024, 32 * (r & 31), 64 * (r >> 5), scr, lane); continue; } r -= T_SQ;
            if (r < T_PRJ) { transpose_item(a.in[28], 1024, 32 * (r & 31), nullptr, (bf16_t*)(ws + WS_W_PROJ0), 256, 32 * (r & 31), 64 * (r >> 5), scr, lane); continue; } r -= T_PRJ;
            if (r < T_PRJ) { transpose_item(a.in[28] + (size_t)PLE * DM, 1024, 32 * (r & 31), nullptr, (bf16_t*)(ws + WS_W_PROJ1), 256, 32 * (r & 31), 64 * (r >> 5), scr, lane); continue; } r -= T_PRJ;
            { const int kb = r >> 7, nb = r & 127, n0 = 32 * nb, type = n0 >> 10, within = n0 & 1023;
              const int scol = 256 * (within >> 8) + 64 * ((within >> 5) & 3) + 32 * ((within >> 7) & 1);
              const float* src = type == 0 ? a.in[15] : (type == 1 ? a.in[16] : a.in[19]); const int ld = type < 2 ? 1024 : 2048;
              const float* gain = type < 2 ? a.in[14] : a.in[18];
              transpose_item(src, ld, scol + (type == 3 ? 1024 : 0), gain, (bf16_t*)(ws + WS_W_QKV), 1024, n0, 64 * kb, scr, lane); }
        } else {
            const int r0 = (it - O_X) * 8; float* ss0 = (float*)(ws + WS_SS0); bf16_t* xb = (bf16_t*)(ws + WS_XB);
            f32x4 v[8][2][2];
#pragma unroll
            for (int rr = 0; rr < 8; ++rr)
#pragma unroll
                for (int j = 0; j < 2; ++j) { const f32x4* xr = (const f32x4*)(a.in[0] + (size_t)(r0 + rr) * DM + (lane + 64 * j) * 8);
                    v[rr][j][0] = __builtin_nontemporal_load(xr); v[rr][j][1] = __builtin_nontemporal_load(xr + 1); }
#pragma unroll
            for (int rr = 0; rr < 8; ++rr) { const int row = r0 + rr; float s = 0.f;
#pragma unroll
                for (int j = 0; j < 2; ++j) { s += sumsq4(v[rr][j][0]) + sumsq4(v[rr][j][1]); *(u32x4*)(xb + (size_t)row * DM + (lane + 64 * j) * 8) = pack8(v[rr][j][0], v[rr][j][1]); }
                s = wave_sum(s); if (lane == 0) ss0[row] = s; }
        }
    }
}

__device__ __forceinline__ void convert_p(const float* p, bf16_t* pb, int layer, bool xl, int XI, int KR, int vcu, int G) {
    const int lane = threadIdx.x & 63, wave = __builtin_amdgcn_readfirstlane(threadIdx.x >> 6);
    const int first = xl ? (16 * XI + (KR & 7) + 8 * (wave >> 2)) * 16 + (KR >> 3) * 4 + (wave & 3) : vcu * 8 + wave, step = xl ? 2048 : G * 8, lim = 2048;
    for (int it = first; it < lim; it += step) {
        const size_t e0 = (size_t)layer * M * PLE + (size_t)it * 4096; const float* sp = p + e0; bf16_t* dp = pb + e0;
        f32x4 v[8][2];
#pragma unroll
        for (int j = 0; j < 8; ++j) { const f32x4* q = (const f32x4*)(sp + (lane + 64 * j) * 8); v[j][0] = __builtin_nontemporal_load(q); v[j][1] = __builtin_nontemporal_load(q + 1); }
#pragma unroll
        for (int j = 0; j < 8; ++j) *(u32x4*)(dp + (lane + 64 * j) * 8) = pack8(v[j][0], v[j][1]);
    }
}

__device__ __forceinline__ void ssm_state_phase(const bf16_t* aext, const bf16_t* w1s, float* S, int vcu, int G) {
    const int lane = threadIdx.x & 63, r32 = lane & 31, hi = lane >> 5, w = __builtin_amdgcn_readfirstlane(threadIdx.x >> 6);
    for (int unit = vcu; unit < 512; unit += G) {
        const int g = unit >> 3, cb = (unit & 7) * 256 + w * 32;
        const bf16_t* arow = aext + ((size_t)(g * NCHUNK + cb + r32)) * KX + 128 + 8 * hi;
        const bf16_t* brow = w1s + ((size_t)g * 128 + r32) * (TC * GC) + 8 * hi;
        f32x16 acc[4];
#pragma unroll
        for (int n = 0; n < 4; ++n) acc[n] = f32x16{};
#pragma unroll 8
        for (int kk = 0; kk < TC * GC / 16; ++kk) {
            const bf16x8 av = *(const bf16x8*)(arow + 16 * kk);
#pragma unroll
            for (int n = 0; n < 4; ++n) { const bf16x8 bv = *(const bf16x8*)(brow + (size_t)n * 32 * (TC * GC) + 16 * kk); acc[n] = __builtin_amdgcn_mfma_f32_32x32x16_bf16(av, bv, acc[n], 0, 0, 0); }
        }
#pragma unroll
        for (int n = 0; n < 4; ++n)
#pragma unroll
            for (int r = 0; r < 16; ++r) S[((size_t)(g * NCHUNK + cb + att::crow(r, hi))) * 128 + n * 32 + r32] = acc[n][r];
    }
}
__device__ __forceinline__ void ssm_scan_phase(const float* S, const float* at, bf16_t* aext, int vcu, int G) {
    const int tid = threadIdx.x;
    if (tid >= 128) return;
    for (int item = vcu; item < 256; item += G) {
        const int idx = item * 128 + tid, p = idx & 63, g = (idx >> 6) & 63, b = idx >> 12;
        const float ar = at[(g * NP + p) * 2], ai = at[(g * NP + p) * 2 + 1]; float hr = 0.f, hi_ = 0.f;
        const size_t base0 = (size_t)g * NCHUNK + (size_t)b * NCK;
        for (int ck0 = 0; ck0 < NCK; ck0 += 32) {
            float sr[32], si[32];
#pragma unroll
            for (int i = 0; i < 32; ++i) { sr[i] = S[(base0 + ck0 + i) * 128 + p]; si[i] = S[(base0 + ck0 + i) * 128 + 64 + p]; }
#pragma unroll
            for (int i = 0; i < 32; ++i) {
                aext[(base0 + ck0 + i) * KX + p] = f2bf(hr); aext[(base0 + ck0 + i) * KX + 64 + p] = f2bf(hi_);
                const float nr = ar * hr - ai * hi_ + sr[i], ni = ar * hi_ + ai * hr + si[i]; hr = nr; hi_ = ni;
            }
        }
    }
}


__device__ __forceinline__ void ssm_state_scan_fused(const bf16_t* aext_c, const bf16_t* w1s, const float* at, bf16_t* aext, LAS unsigned char* lds, int vcu, bool xl, int XI, int KR) {
    const int tid = threadIdx.x, lane = tid & 63, r32 = lane & 31, hi = lane >> 5, w = __builtin_amdgcn_readfirstlane(tid >> 6);
    LAS float* Sl = (LAS float*)lds;
    LAS float* Eb = (LAS float*)(lds + 256 * 129 * 4);
#pragma unroll 1
    for (int ui = 0; ui < 2; ++ui) {
        const int L = vcu + 256 * ui, g = xl ? KR * 2 + ui : L >> 3, cb0 = (xl ? XI : (L & 7)) * NCK;
        {
            const bf16_t* wg = w1s + (size_t)g * 128 * (TC * GC);
#pragma unroll
            for (int j = 0; j < 8; ++j) { const int q = j * 512 + tid, row = q >> 5, kg = (q & 31) ^ (row & 31);
                __builtin_amdgcn_global_load_lds((const unsigned*)(wg + (size_t)row * (TC * GC) + kg * 8), (LAS unsigned*)(lds + j * 8192 + w * 1024), 16, 0, 0); }
            const int cb = cb0 + w * 32;
            const bf16_t* arow = aext_c + ((size_t)(g * NCHUNK + cb + r32)) * KX + 128 + 8 * hi;
            f32x16 acc[4];
#pragma unroll
            for (int n = 0; n < 4; ++n) acc[n] = f32x16{};
            asm volatile("s_waitcnt vmcnt(0)" ::: "memory");
            __syncthreads();
#pragma unroll 8
            for (int kk = 0; kk < TC * GC / 16; ++kk) {
                const bf16x8 av = *(const bf16x8*)(arow + 16 * kk);
#pragma unroll
                for (int n = 0; n < 4; ++n) { const bf16x8 bv = *(const LAS bf16x8*)(lds + ((n * 32 + r32) * 32 + ((2 * kk + hi) ^ r32)) * 16); acc[n] = __builtin_amdgcn_mfma_f32_32x32x16_bf16(av, bv, acc[n], 0, 0, 0); }
            }
            __syncthreads();
#pragma unroll
            for (int n = 0; n < 4; ++n)
#pragma unroll
                for (int r = 0; r < 16; ++r) Sl[(w * 32 + att::crow(r, hi)) * 129 + n * 32 + r32] = acc[n][r];
        }
        __syncthreads();
        const int p = tid & 63, seg = __builtin_amdgcn_readfirstlane(tid >> 6);
        float ar = 0.f, ai = 0.f;
        LAS float* sp = Sl + (seg * 64) * 129 + p;
        if (tid < 256) {
            ar = at[(g * NP + p) * 2]; ai = at[(g * NP + p) * 2 + 1]; float hr = 0.f, hi_ = 0.f;
#pragma unroll 8
            for (int ck = 0; ck < 64; ++ck) { const float sr = sp[ck * 129], si = sp[ck * 129 + 64]; const float nr = ar * hr - ai * hi_ + sr, ni = ar * hi_ + ai * hr + si; hr = nr; hi_ = ni; }
            Eb[(seg * 64 + p) * 2] = hr; Eb[(seg * 64 + p) * 2 + 1] = hi_;
        }
        __syncthreads();
        if (tid < 256) {
            float qr = ar, qi = ai;
#pragma unroll
            for (int k = 0; k < 6; ++k) { const float nr = qr * qr - qi * qi, ni = 2.f * qr * qi; qr = nr; qi = ni; }
            float hr = 0.f, hi_ = 0.f;
            for (int sg = 0; sg < seg; ++sg) { const float er = Eb[(sg * 64 + p) * 2], ei = Eb[(sg * 64 + p) * 2 + 1]; const float nr = qr * hr - qi * hi_ + er, ni = qr * hi_ + qi * hr + ei; hr = nr; hi_ = ni; }
#pragma unroll 8
            for (int ck = 0; ck < 64; ++ck) {
                const float sr = sp[ck * 129], si = sp[ck * 129 + 64];
                ((LAS unsigned*)sp)[ck * 129] = (unsigned)f2bf(hr) | ((unsigned)f2bf(hi_) << 16);
                const float nr = ar * hr - ai * hi_ + sr, ni = ar * hi_ + ai * hr + si; hr = nr; hi_ = ni;
            }
        }
        __syncthreads();
        {
            for (int pc = tid; pc < 256 * 16; pc += 512) { const int row = pc >> 4, j = pc & 15, isim = j >> 3, p0 = (j & 7) * 8;
                const LAS unsigned* wp = (const LAS unsigned*)Sl + row * 129 + p0;
                unsigned v[8];
#pragma unroll
                for (int e = 0; e < 8; ++e) v[e] = isim ? (wp[e] >> 16) : (wp[e] & 0xffffu);
                u32x4 o; o.x = v[0] | (v[1] << 16); o.y = v[2] | (v[3] << 16); o.z = v[4] | (v[5] << 16); o.w = v[6] | (v[7] << 16);
                *(u32x4*)(aext + ((size_t)g * NCHUNK + cb0 + row) * KX + isim * 64 + p0) = o; }
            asm volatile("s_waitcnt vmcnt(0)" ::: "memory");
        }
        __syncthreads();
    }
}

#ifndef USE_CG_SYNC
#define USE_CG_SYNC 0
#endif
#define XB_TMO      128
#define XB_XCNT(j)  (256  + 64 * (j))
#define XB_XSUB(j)  (1280 + 64 * (j))
#define XB_XGEN(j)  (2304 + 64 * (j))
#define XB_TOP      3328
#define XB_TOPGEN   3392
#define XB_GCNT(j, g) (3520 + 64 * (j) + (g))
#define XCD_BAR_WORDS 4544
#define XB_SPIN_CAP (1u << 20)
__device__ __forceinline__ unsigned xb_ld(unsigned* p)              { return __hip_atomic_load(p, __ATOMIC_RELAXED, __HIP_MEMORY_SCOPE_AGENT); }
__device__ __forceinline__ unsigned xb_add(unsigned* p, unsigned v) { return __hip_atomic_fetch_add(p, v, __ATOMIC_RELAXED, __HIP_MEMORY_SCOPE_AGENT); }
__device__ __forceinline__ unsigned xb_xcc_id() { return (unsigned)__builtin_amdgcn_s_getreg((3 << 11) | 20) & 0xFu; }
#define XB_SPIN(cond, bar) do { unsigned _sp = 0; while (cond) { __builtin_amdgcn_s_sleep(1); \
    if ((++_sp & 255u) == 0u) { if (xb_ld(&(bar)[XB_TMO])) break; if (_sp > XB_SPIN_CAP) { atomicAdd(&(bar)[XB_TMO], 1u); break; } } } } while (0)
struct XcdBarrier { unsigned* bar; unsigned x; volatile LAS unsigned* st; };
__device__ __forceinline__ XcdBarrier xcd_barrier_post(unsigned* bar, volatile LAS unsigned* st) {
    XcdBarrier b; b.bar = bar; b.x = xb_xcc_id(); b.st = st;
    if (threadIdx.x == 0) st[2] = xb_add(&bar[XB_XCNT(b.x)], 1u);
    return b;
}
__device__ __forceinline__ void xcd_barrier_complete(unsigned* bar, unsigned x, unsigned& nloc, unsigned& nx) {
    const unsigned G = gridDim.x * gridDim.y * gridDim.z;
    unsigned sum, cnt, mine, sp = 0u;
    for (;;) {
        sum = 0u; cnt = 0u; mine = 0u;
#pragma unroll
        for (unsigned j = 0; j < 16; ++j) { const unsigned c = xb_ld(&bar[XB_XCNT(j)]); sum += c; cnt += (c > 0u) ? 1u : 0u; mine = (j == x) ? c : mine; }
        if (sum == G) break;
        __builtin_amdgcn_s_sleep(1);
        if ((++sp & 255u) == 0u) { if (xb_ld(&bar[XB_TMO])) break; if (sp > XB_SPIN_CAP) { atomicAdd(&bar[XB_TMO], 1u); break; } }
    }
    nloc = mine > 0u ? mine : 1u; nx = cnt > 0u ? cnt : 1u;
}
__device__ __forceinline__ void xcd_census_shape(unsigned* bar, unsigned x, unsigned& xidx, unsigned& regular) {
    unsigned idx = 0u, npop = 0u, ok = 1u;
#pragma unroll
    for (unsigned j = 0; j < 16; ++j) { const unsigned c = xb_ld(&bar[XB_XCNT(j)]); if (c > 0u) { npop++; if (j < x) idx++; if (c != 32u) ok = 0u; } }
    xidx = idx; regular = (ok && npop == 8u) ? 1u : 0u;
}
__device__ __forceinline__ void xcd_barrier(const XcdBarrier& b, bool local_only = false) {
    asm volatile("s_waitcnt vmcnt(0)" ::: "memory");
    __syncthreads();
    if (threadIdx.x == 0) {
        unsigned* bar = b.bar;
        __builtin_amdgcn_s_waitcnt(0);
        unsigned nloc = b.st[0], nx = b.st[1];
        if (nloc == 0u) { xcd_barrier_complete(bar, b.x, nloc, nx); unsigned xi, rg; xcd_census_shape(bar, b.x, xi, rg); b.st[3] = xi; b.st[4] = rg; b.st[0] = nloc; b.st[1] = nx; }
        const unsigned old = xb_add(&bar[XB_XSUB(b.x)], 1u);
        const unsigned gen = old / nloc;
        if (old + 1u == (gen + 1u) * nloc) {
            if (!local_only) {
            __builtin_amdgcn_fence(__ATOMIC_RELEASE, "agent");
            asm volatile("s_waitcnt vmcnt(0)" ::: "memory");
            const unsigned og = xb_add(&bar[XB_TOP], 1u);
            const unsigned tg = og / nx;
            if (og + 1u == (tg + 1u) * nx) xb_add(&bar[XB_TOPGEN], 1u);
            else XB_SPIN(xb_ld(&bar[XB_TOPGEN]) == tg, bar);
            }
            __builtin_amdgcn_fence(__ATOMIC_ACQUIRE, "agent");
            xb_add(&bar[XB_XGEN(b.x)], 1u);
            asm volatile("s_waitcnt vmcnt(0)" ::: "memory");
        } else {
            XB_SPIN(xb_ld(&bar[XB_XGEN(b.x)]) == gen, bar);
            __builtin_amdgcn_fence(__ATOMIC_ACQUIRE, "agent");
            asm volatile("s_waitcnt vmcnt(0)" ::: "memory");
        }
    }
    __syncthreads();
}
__device__ __forceinline__ void xcd_barrier_local_arrive(const XcdBarrier& b) {
    asm volatile("s_waitcnt vmcnt(0)" ::: "memory");
    __syncthreads();
    if (threadIdx.x == 0) {
        unsigned* bar = b.bar;
        __builtin_amdgcn_s_waitcnt(0);
        const unsigned nloc = b.st[0];
        const unsigned old = xb_add(&bar[XB_XSUB(b.x)], 1u);
        const unsigned gen = old / nloc;
        if (old + 1u == (gen + 1u) * nloc) { xb_add(&bar[XB_XGEN(b.x)], 1u); b.st[5] = 0xffffffffu; }
        else b.st[5] = gen;
    }
}
__device__ __forceinline__ void xcd_barrier_local_wait(const XcdBarrier& b) {
    if (threadIdx.x == 0) {
        unsigned* bar = b.bar;
        const unsigned gen = b.st[5];
        if (gen != 0xffffffffu) XB_SPIN(xb_ld(&bar[XB_XGEN(b.x)]) == gen, bar);
        __builtin_amdgcn_fence(__ATOMIC_ACQUIRE, "agent");
        asm volatile("s_waitcnt vmcnt(0)" ::: "memory");
    }
    __syncthreads();
}
__device__ __forceinline__ void grp_barrier(const XcdBarrier& b, int g) {
    asm volatile("s_waitcnt vmcnt(0)" ::: "memory");
    __syncthreads();
    if (threadIdx.x == 0) {
        unsigned* c = &b.bar[XB_GCNT(b.x, g)];
        __builtin_amdgcn_s_waitcnt(0);
        const unsigned old = xb_add(c, 1u);
        const unsigned target = (old / 4u + 1u) * 4u;
        XB_SPIN(xb_ld(c) < target, b.bar);
        __builtin_amdgcn_fence(__ATOMIC_ACQUIRE, "agent");
        asm volatile("s_waitcnt vmcnt(0)" ::: "memory");
    }
    __syncthreads();
}
constexpr int LDS_XB_OFF = 140 * 1024;
constexpr size_t CTL_ZERO_BYTES = 65536;

__global__ void __launch_bounds__(512, 2) fwd_kernel(Args args) {
    extern __shared__ __attribute__((aligned(16))) unsigned char lds_raw[];
    LAS unsigned char* lds = (LAS unsigned char*)lds_raw;
    const int G = gridDim.x, bx = blockIdx.x;
    const int vcu = (G % 8 == 0) ? (bx % 8) * (G / 8) + bx / 8 : bx;
    unsigned char* ws = args.ws;
    const int lo = args.ph_lo, hi = args.ph_hi;
#define IN(k) (lo <= (k) && (k) < hi)
#if USE_CG_SYNC
#define SEAM(k) do { if (IN(k) && IN((k) + 1)) { cg::this_grid().sync(); } } while (0)
#else
    XcdBarrier bar; bar.bar = (unsigned*)ws + 1024; bar.x = 0; bar.st = nullptr;
    if (hi - lo > 1) {
        volatile LAS unsigned* st = (volatile LAS unsigned*)(lds + LDS_XB_OFF);
        if (threadIdx.x < 8) st[threadIdx.x] = 0u;
        __syncthreads();
        bar = xcd_barrier_post((unsigned*)ws + 1024, st);
    }
#define SEAM(k) do { if (IN(k) && IN((k) + 1)) { xcd_barrier(bar); } } while (0)
#endif
    float* xs = args.out;
    if (IN(0)) { prologue(args, lds, vcu, G); }
    SEAM(0);
#if !USE_CG_SYNC
    const bool xl = (hi - lo > 1) && lo == 0 && hi >= 12 && G == 256 && __builtin_amdgcn_readfirstlane((int)bar.st[4]) != 0;
    const int XI = xl ? __builtin_amdgcn_readfirstlane((int)bar.st[3]) : 0, KR = xl ? (__builtin_amdgcn_readfirstlane((int)bar.st[2]) & 31) : 0;
#define SEAMX(k) do { if (IN(k) && IN((k) + 1)) { xcd_barrier(bar, xl); } } while (0)
#define SEAMG(k) do { if (IN(k) && IN((k) + 1)) { if (xl) grp_barrier(bar, KR & 7); else xcd_barrier(bar); } } while (0)
#else
    const bool xl = false; const int XI = 0, KR = 0;
#define SEAMX(k) SEAM(k)
#define SEAMG(k) SEAM(k)
#endif
    if (IN(1)) {
        { pg8::Gemm g{(const bf16_t*)(ws + WS_XB), (const bf16_t*)(ws + WS_W_IN0), DM, DM}; pg8::DualOrder S; S.init(M, 2048, DM, G, bx, xl, XI, KR);
          const LAS float* rl_ = nullptr; if (xl) { pg8::row_scales1_to_lds((const float*)(ws + WS_SS0), 16 * XI + (KR & 7), (LAS float*)(lds + pg8::LDS_RS_OFF)); rl_ = (const LAS float*)(lds + pg8::LDS_RS_OFF); }
          pg8::EpiInProj E{(const float*)(ws + WS_SS0), (bf16_t*)(ws + WS_AEXT), (bf16_t*)(ws + WS_SZ0), rl_};
          pg8::gemm_phase<pg8::EpiInProj, pg8::DualOrder, true>(lds, g, S, E); }
    }
    SEAMX(1);
    const bool ssm_fused = (G == 256) && IN(2) && IN(3) && IN(4);
    if (ssm_fused) ssm_state_scan_fused((const bf16_t*)(ws + WS_AEXT), (const bf16_t*)(ws + WS_W1S), (const float*)(ws + WS_AT), (bf16_t*)(ws + WS_AEXT), lds, vcu, xl, XI, KR);
    else {
    if (IN(2)) ssm_state_phase((const bf16_t*)(ws + WS_AEXT), (const bf16_t*)(ws + WS_W1S), (float*)(ws + WS_S), vcu, G);
    SEAM(2);
    if (IN(3)) ssm_scan_phase((const float*)(ws + WS_S), (const float*)(ws + WS_AT), (bf16_t*)(ws + WS_AEXT), vcu, G);
    SEAM(3);
    }
    if (IN(4)) { pg8::Gemm g{(const bf16_t*)(ws + WS_AEXT), (const bf16_t*)(ws + WS_BTS), KX, KX}; pg8::SsmOrder S{G, vcu, xl, XI, KR};
        pg8::EpiY E{(bf16_t*)(ws + WS_YB)}; pg8::gemm_phase<pg8::EpiY, pg8::SsmOrder, true>(lds, g, S, E); }
    if (xl && IN(4) && IN(5)) { xcd_barrier_local_arrive(bar); convert_p(args.in[1], (bf16_t*)(ws + WS_PB), 0, xl, XI, KR, vcu, G); xcd_barrier_local_wait(bar); }
    else { SEAMX(4); if (IN(5)) convert_p(args.in[1], (bf16_t*)(ws + WS_PB), 0, xl, XI, KR, vcu, G); }
    if (IN(5)) { pg8::Gemm g{(const bf16_t*)(ws + WS_YB), (const bf16_t*)(ws + WS_W_GLU), M, DM}; pg8::DualOrder S; S.init(M, 2048, DM, G, bx, xl, XI, KR);
        pg8::EpiGlu E{(const bf16_t*)(ws + WS_SZ0), (bf16_t*)(ws + WS_GB)}; pg8::gemm_phase<pg8::EpiGlu, pg8::DualOrder, true, 1>(lds, g, S, E); }
    SEAMG(5);
    const bool pflip = xl && ((XI + KR) & 1);
    if (IN(6) && (pflip || !xl)) { pg8::Gemm g{(const bf16_t*)(ws + WS_PB), (const bf16_t*)(ws + WS_W_PROJ0), PLE, PLE}; pg8::DualOrder S; S.init(M, DM, PLE, G, bx, xl, XI, KR);
        pg8::EpiStore E{(bf16_t*)(ws + WS_PP0)}; pg8::gemm_phase<pg8::EpiStore, pg8::DualOrder, true>(lds, g, S, E); }
    if (IN(6)) { pg8::Gemm g{(const bf16_t*)(ws + WS_GB), (const bf16_t*)(ws + WS_W_OUT0), DM, DM}; pg8::DualOrder S; S.init(M, DM, DM, G, bx, xl, XI, KR);
        pg8::EpiOutRes<true, false> E{nullptr, (const bf16_t*)(ws + WS_XB), (bf16_t*)(ws + WS_X1B), (float*)(ws + WS_SSP1)}; pg8::gemm_phase<pg8::EpiOutRes<true, false>, pg8::DualOrder, true, 3>(lds, g, S, E); }
    if (IN(6) && xl && !pflip) { pg8::Gemm g{(const bf16_t*)(ws + WS_PB), (const bf16_t*)(ws + WS_W_PROJ0), PLE, PLE}; pg8::DualOrder S; S.init(M, DM, PLE, G, bx, xl, XI, KR);
        pg8::EpiStore E{(bf16_t*)(ws + WS_PP0)}; pg8::gemm_phase<pg8::EpiStore, pg8::DualOrder, true>(lds, g, S, E); }
    SEAMG(6);
    if (IN(7)) { pg8::Gemm g{(const bf16_t*)(ws + WS_X1B), (const bf16_t*)(ws + WS_W_GATE0), DM, DM}; pg8::DualOrder S; S.init(M, DM, DM, G, bx, xl, XI, KR);
        const LAS float* rl_ = nullptr; if (xl) { pg8::row_scales_to_lds((const float*)(ws + WS_SSP1), 16 * XI + (KR & 7), (LAS float*)(lds + pg8::LDS_RS_OFF)); rl_ = (const LAS float*)(lds + pg8::LDS_RS_OFF); }
        pg8::EpiGate<false> E{(const bf16_t*)(ws + WS_X1B), (const bf16_t*)(ws + WS_PP0), (const float*)(ws + WS_SSP1), (bf16_t*)(ws + WS_X2B), (float*)(ws + WS_SSP2), nullptr, rl_};
        pg8::gemm_phase<pg8::EpiGate<false>, pg8::DualOrder, true, 3>(lds, g, S, E); }
    SEAMG(7);
    if (IN(8)) { pg8::Gemm g{(const bf16_t*)(ws + WS_X2B), (const bf16_t*)(ws + WS_W_QKV), DM, DM}; pg8::DualOrder S; S.init(M, 4096, DM, G, bx, xl, XI, KR);
        const LAS float* rl_ = nullptr; if (xl) { pg8::row_scales_to_lds((const float*)(ws + WS_SSP2), 16 * XI + (KR & 7), (LAS float*)(lds + pg8::LDS_RS_OFF)); rl_ = (const LAS float*)(lds + pg8::LDS_RS_OFF); }
        pg8::EpiQKV E{(const float*)(ws + WS_SSP2), args.in[17], args.in[20], (bf16_t*)(ws + WS_K), (bf16_t*)(ws + WS_V), (bf16_t*)(ws + WS_Q), (bf16_t*)(ws + WS_SZ1), 0.125f * LOG2E, rl_};
        pg8::gemm_phase<pg8::EpiQKV, pg8::DualOrder, true, 3>(lds, g, S, E); }
    if (xl && IN(8) && IN(9)) { xcd_barrier_local_arrive(bar); convert_p(args.in[1], (bf16_t*)(ws + WS_PB), 1, xl, XI, KR, vcu, G); xcd_barrier_local_wait(bar); }
    else { SEAMX(8); if (IN(9)) convert_p(args.in[1], (bf16_t*)(ws + WS_PB), 1, xl, XI, KR, vcu, G); }
    if (IN(9)) { att::Params P{(const bf16_t*)(ws + WS_Q), (const bf16_t*)(ws + WS_K), (const bf16_t*)(ws + WS_V), (const bf16_t*)(ws + WS_SZ1), (bf16_t*)(ws + WS_OG),
                               args.in[27], args.in[20], args.in[17], args.in[21], args.in[22], args.in[23], args.in[24], args.in[25]};
        att2::attn_phase(P, lds, xl ? XI * 32 + KR : vcu, G); }
    SEAMX(9);
    if (IN(10) && (pflip || !xl)) { pg8::Gemm g{(const bf16_t*)(ws + WS_PB) + (size_t)M * PLE, (const bf16_t*)(ws + WS_W_PROJ1), PLE, PLE}; pg8::DualOrder S; S.init(M, DM, PLE, G, bx, xl, XI, KR);
        pg8::EpiStore E{(bf16_t*)(ws + WS_PP1)}; pg8::gemm_phase<pg8::EpiStore, pg8::DualOrder, true>(lds, g, S, E); }
    if (IN(10)) { pg8::Gemm g{(const bf16_t*)(ws + WS_OG), (const bf16_t*)(ws + WS_W_OUT1), DM, DM}; pg8::DualOrder S; S.init(M, DM, DM, G, bx, xl, XI, KR);
        pg8::EpiOutRes<true> E{nullptr, (const bf16_t*)(ws + WS_X2B), (bf16_t*)(ws + WS_X3B), (float*)(ws + WS_SSP3)}; pg8::gemm_phase<pg8::EpiOutRes<true>, pg8::DualOrder, true>(lds, g, S, E); }
    if (IN(10) && xl && !pflip) { pg8::Gemm g{(const bf16_t*)(ws + WS_PB) + (size_t)M * PLE, (const bf16_t*)(ws + WS_W_PROJ1), PLE, PLE}; pg8::DualOrder S; S.init(M, DM, PLE, G, bx, xl, XI, KR);
        pg8::EpiStore E{(bf16_t*)(ws + WS_PP1)}; pg8::gemm_phase<pg8::EpiStore, pg8::DualOrder, true>(lds, g, S, E); }
    SEAMG(10);
    if (IN(11)) { pg8::Gemm g{(const bf16_t*)(ws + WS_X3B), (const bf16_t*)(ws + WS_W_GATE1), DM, DM}; pg8::DualOrder S; S.init(M, DM, DM, G, bx, xl, XI, KR);
        const LAS float* rl_ = nullptr; if (xl) { pg8::row_scales_to_lds((const float*)(ws + WS_SSP3), 16 * XI + (KR & 7), (LAS float*)(lds + pg8::LDS_RS_OFF)); rl_ = (const LAS float*)(lds + pg8::LDS_RS_OFF); }
        pg8::EpiGate<true> E{(const bf16_t*)(ws + WS_X3B), (const bf16_t*)(ws + WS_PP1), (const float*)(ws + WS_SSP3), nullptr, nullptr, xs, rl_};
        pg8::gemm_phase<pg8::EpiGate<true>, pg8::DualOrder, true, 3>(lds, g, S, E); }
#undef SEAMX
#undef SEAMG
#undef IN
#undef SEAM
}

extern "C" void kernel_launch(void* const* d_in, const int* in_sizes, int n_in, void* d_out, int out_size, void* d_ws, size_t ws_size, hipStream_t stream) {
    static int grid = 0;
    if (grid == 0) {
        if (n_in != 30 || in_sizes[0] != M * DM || out_size != M * DM || ws_size < WS_END) { fprintf(stderr, "kernel_launch: unexpected shapes (n_in %d, in0 %d, out %d, ws %zu)\n", n_in, n_in > 0 ? in_sizes[0] : -1, out_size, ws_size); grid = -1; return; }
        int dev = 0, cus = 0, per_cu = 0;
        if (hipGetDevice(&dev) != hipSuccess || hipDeviceGetAttribute(&cus, hipDeviceAttributeMultiprocessorCount, dev) != hipSuccess) { grid = -1; return; }
        if (hipFuncSetAttribute((const void*)fwd_kernel, hipFuncAttributeMaxDynamicSharedMemorySize, LDS_BYTES) != hipSuccess) { fprintf(stderr, "kernel_launch: hipFuncSetAttribute failed\n"); grid = -1; return; }
        if (hipOccupancyMaxActiveBlocksPerMultiprocessor(&per_cu, (const void*)fwd_kernel, 512, LDS_BYTES) != hipSuccess || per_cu < 1) { fprintf(stderr, "kernel_launch: occupancy query failed (%d)\n", per_cu); (void)hipGetLastError(); grid = -1; return; }
        grid = cus * 1;
        fprintf(stderr, "kernel_launch: grid %d (cus %d, per_cu %d)\n", grid, cus, per_cu);
    }
    if (grid < 0) return;
    Args a{};
    for (int i = 0; i < 30; ++i) a.in[i] = (const float*)d_in[i];
    a.out = (float*)d_out; a.ws = (unsigned char*)d_ws;
#if MK_N_LAUNCHES == 1
    a.ph_lo = 0; a.ph_hi = 12;
#if !USE_CG_SYNC
    if (hipMemsetAsync(d_ws, 0, CTL_ZERO_BYTES, stream) != hipSuccess) { fprintf(stderr, "kernel_launch: hipMemsetAsync failed\n"); return; }
#endif
    void* kargs[] = {&a};
    hipError_t e = hipLaunchCooperativeKernel((const void*)fwd_kernel, dim3(grid), dim3(512), kargs, LDS_BYTES, stream);
    if (e != hipSuccess) fprintf(stderr, "kernel_launch: cooperative launch failed: %s (grid %d)\n", hipGetErrorString(e), grid);
#else
    for (int ph = 0; ph < 12; ++ph) { a.ph_lo = ph; a.ph_hi = ph + 1;
        for (int rep = 0; rep < 1 + ((PROBE_MASK >> ph) & 1); ++rep) hipLaunchKernelGGL(fwd_kernel, dim3(grid), dim3(512), LDS_BYTES, stream, a); }
#endif
}
```
